# Optimizing an MI355X kernel written in HIP

```python
import jax, jax.numpy as jnp
from jax import lax
import numpy as np

D_MODEL = 1024
BATCH = 8
SEQ = 2048
DEPTH = 4

N_META = 16
EXPAND = 2
D_INNER = EXPAND * D_MODEL
N_A = DEPTH // 2
N_B = DEPTH - N_A
GLA_HEADS = 4
GLA_DK_TOTAL = D_INNER // 2
GLA_HEAD_K = GLA_DK_TOTAL // GLA_HEADS
GLA_HEAD_V = D_INNER // GLA_HEADS
GLA_GATE_RANK = 16
GLA_GATE_NORMALIZER = 16.0
GLA_CHUNK = 16
GLA_IN_COLS = 2 * GLA_DK_TOTAL + D_INNER + GLA_GATE_RANK + D_INNER
FOX_HEADS = 16
FOX_HEAD_DIM = D_INNER // FOX_HEADS
FOX_BLOCK = 128
FOX_IN_COLS = 2 * D_INNER
KV_COLS = 2 * D_INNER + FOX_HEADS
RMS_EPS = 1e-6
NEG_INF = -1e30

kernel_name = "gla_fox_yoco_meta_hybrid"


def rmsnorm(x, g):
    xf = x.astype(jnp.float32)
    y = xf * lax.rsqrt(jnp.mean(xf * xf, axis=-1, keepdims=True) + RMS_EPS)
    return (y * g.astype(jnp.float32)).astype(x.dtype)


def gla_chunked(q, k, v, log_a):
    B, L, H, dk = q.shape
    dv = v.shape[-1]
    n_chunks = L // GLA_CHUNK

    def to_chunks(t):
        return t.reshape(B, n_chunks, GLA_CHUNK, H, t.shape[-1]).transpose(1, 0, 3, 2, 4)

    qc, kc, vc, gc = to_chunks(q), to_chunks(k), to_chunks(v), to_chunks(log_a.astype(jnp.float32))
    causal = jnp.tril(jnp.ones((GLA_CHUNK, GLA_CHUNK), dtype=bool))

    def step(S, inp):
        qn, kn, vn, gn = inp
        b = jnp.cumsum(gn, axis=-2)
        b_last = b[..., -1:, :]
        q_dec = qn * jnp.exp(b)
        k_inv = kn * jnp.exp(-b)
        k_rem = kn * jnp.exp(b_last - b)
        attn = jnp.where(causal, jnp.einsum('bhik,bhjk->bhij', q_dec, k_inv), 0.0)
        o = jnp.einsum('bhij,bhjv->bhiv', attn, vn) + jnp.einsum('bhik,bhkv->bhiv', q_dec, S)
        S = jnp.exp(b_last[..., 0, :])[..., None] * S + jnp.einsum('bhjk,bhjv->bhkv', k_rem, vn)
        return S, o

    S0 = jnp.zeros((B, H, dk, dv), jnp.float32)
    _, o = lax.scan(step, S0, (qc, kc, vc, gc))
    return o.transpose(1, 0, 3, 2, 4).reshape(B, L, H, dv).astype(v.dtype)


def gla_layer(h, norm_g, w_in, w_gate_up, b_gate, head_norm_g, w_out):
    B, L, _ = h.shape
    proj = rmsnorm(h, norm_g) @ w_in
    o1 = GLA_DK_TOTAL
    o2 = 2 * GLA_DK_TOTAL
    o3 = o2 + D_INNER
    o4 = o3 + GLA_GATE_RANK
    q, k, v, g_low, r = jnp.split(proj, [o1, o2, o3, o4], axis=-1)
    log_a = jax.nn.log_sigmoid((g_low @ w_gate_up + b_gate).astype(jnp.float32)) / GLA_GATE_NORMALIZER
    q = q.reshape(B, L, GLA_HEADS, GLA_HEAD_K) * (GLA_HEAD_K ** -0.5)
    k = k.reshape(B, L, GLA_HEADS, GLA_HEAD_K)
    v = v.reshape(B, L, GLA_HEADS, GLA_HEAD_V)
    log_a = log_a.reshape(B, L, GLA_HEADS, GLA_HEAD_K)
    o = gla_chunked(q, k, v, log_a)
    o = rmsnorm(o, head_norm_g).reshape(B, L, D_INNER)
    return h + (o * jax.nn.silu(r)) @ w_out


def fox_shared_kv(h, kv_norm_g, w_kv, b_forget):
    B, L, _ = h.shape
    proj = rmsnorm(h, kv_norm_g) @ w_kv
    k, v, f_logit = jnp.split(proj, [D_INNER, 2 * D_INNER], axis=-1)
    k = k.reshape(B, L, FOX_HEADS, FOX_HEAD_DIM).transpose(0, 2, 1, 3)
    v = v.reshape(B, L, FOX_HEADS, FOX_HEAD_DIM).transpose(0, 2, 1, 3)
    log_f = jax.nn.log_sigmoid((f_logit + b_forget).astype(jnp.float32))
    cum = jnp.cumsum(log_f, axis=1).transpose(0, 2, 1)
    return k, v, cum


def fox_layer(h, norm_g, w_in, w_out, k, v, cum):
    B, L, _ = h.shape
    q, r = jnp.split(rmsnorm(h, norm_g) @ w_in, 2, axis=-1)
    q = q.reshape(B, L, FOX_HEADS, FOX_HEAD_DIM).transpose(0, 2, 1, 3) * (FOX_HEAD_DIM ** -0.5)
    bounds = [0, N_META] + list(range(N_META + FOX_BLOCK, L + 1, FOX_BLOCK))
    outs = []
    for start, end in zip(bounds[:-1], bounds[1:]):
        s = jnp.einsum('bhqd,bhkd->bhqk', q[:, :, start:end], k[:, :, :end]).astype(jnp.float32)
        s = s + cum[:, :, start:end, None] - cum[:, :, None, :end]
        causal = jnp.arange(start, end)[:, None] >= jnp.arange(end)[None, :]
        p = jax.nn.softmax(jnp.where(causal, s, NEG_INF), axis=-1)
        outs.append(jnp.einsum('bhqk,bhkd->bhqd', p.astype(v.dtype), v[:, :, :end]))
    o = jnp.concatenate(outs, axis=2).transpose(0, 2, 1, 3).reshape(B, L, D_INNER)
    return h + (o * jax.nn.silu(r)) @ w_out


def setup_inputs(seed: int = 0) -> dict:
    key = jax.random.key(seed)
    ks = jax.random.split(key, 16)
    f32 = jnp.float32
    nrm = lambda k, shape, scale: jax.random.normal(k, shape, f32) * scale
    return {
        "x": nrm(ks[0], (BATCH, SEQ, D_MODEL), 1.0),
        "meta_tokens": nrm(ks[1], (N_META, D_MODEL), 1.0),
        "norm_g": 1.0 + nrm(ks[2], (DEPTH, D_MODEL), 0.02),
        "gla_w_in": nrm(ks[3], (N_A, D_MODEL, GLA_IN_COLS), D_MODEL ** -0.5),
        "gla_w_gate_up": nrm(ks[4], (N_A, GLA_GATE_RANK, GLA_DK_TOTAL), GLA_GATE_RANK ** -0.5),
        "gla_b_gate": nrm(ks[5], (N_A, GLA_DK_TOTAL), 0.02),
        "gla_head_norm_g": 1.0 + nrm(ks[6], (N_A, GLA_HEAD_V), 0.02),
        "gla_w_out": nrm(ks[7], (N_A, D_INNER, D_MODEL), 0.5 * D_INNER ** -0.5),
        "kv_norm_g": 1.0 + nrm(ks[8], (D_MODEL,), 0.02),
        "fox_w_kv": nrm(ks[9], (D_MODEL, KV_COLS), D_MODEL ** -0.5),
        "fox_b_forget": nrm(ks[10], (FOX_HEADS,), 0.02),
        "fox_w_in": nrm(ks[11], (N_B, D_MODEL, FOX_IN_COLS), D_MODEL ** -0.5),
        "fox_w_out": nrm(ks[12], (N_B, D_INNER, D_MODEL), 0.5 * D_INNER ** -0.5),
        "final_norm_g": 1.0 + nrm(ks[13], (D_MODEL,), 0.02),
    }


def reference(x, meta_tokens, norm_g, gla_w_in, gla_w_gate_up, gla_b_gate, gla_head_norm_g,
              gla_w_out, kv_norm_g, fox_w_kv, fox_b_forget, fox_w_in, fox_w_out, final_norm_g):
    B = x.shape[0]
    meta = jnp.broadcast_to(meta_tokens[None].astype(x.dtype), (B, N_META, D_MODEL))
    h = jnp.concatenate([meta, x], axis=1)
    k_sh = v_sh = cum_sh = None
    for layer in range(DEPTH):
        if layer < N_A:
            h = gla_layer(h, norm_g[layer], gla_w_in[layer], gla_w_gate_up[layer], gla_b_gate[layer],
                          gla_head_norm_g[layer], gla_w_out[layer])
        else:
            if layer == N_A:
                k_sh, v_sh, cum_sh = fox_shared_kv(h, kv_norm_g, fox_w_kv, fox_b_forget)
            j = layer - N_A
            h = fox_layer(h, norm_g[layer], fox_w_in[j], fox_w_out[j], k_sh, v_sh, cum_sh)
    h = rmsnorm(h, final_norm_g)
    return h[:, N_META:]
```

```cpp
#include <hip/hip_runtime.h>
#include <hip/hip_cooperative_groups.h>
#include <cstdio>
namespace cg = cooperative_groups;

typedef unsigned short u16;
typedef unsigned int u32;
typedef short s16x4 __attribute__((ext_vector_type(4)));
typedef short bf16x8 __attribute__((ext_vector_type(8)));
typedef float f32x16 __attribute__((ext_vector_type(16)));
typedef float f32x2 __attribute__((ext_vector_type(2)));
typedef __bf16 bf16x2_t __attribute__((ext_vector_type(2)));
typedef u32 u32x4 __attribute__((ext_vector_type(4)));
typedef u32 u32x2 __attribute__((ext_vector_type(2)));

#define DI __device__ __forceinline__
#define MFMA(a, b, c) __builtin_amdgcn_mfma_f32_32x32x16_bf16((a), (b), (c), 0, 0, 0)

constexpr int NB = 8, LL = 2064, TT = NB * LL;
constexpr size_t SLOT = (size_t)TT * 2048 * 2;
constexpr size_t OFF_S0 = 0, OFF_S1 = SLOT, OFF_S2 = 2 * SLOT, OFF_W = 3 * SLOT;
constexpr int WPAD = 64;
constexpr size_t WIN_SZ = (size_t)6272 * (1024 + WPAD) * 2;
constexpr size_t W4M = (size_t)2048 * (1024 + WPAD) * 2;
constexpr size_t OFF_WIN = OFF_W;
constexpr size_t OFF_WOUT = OFF_W + 2 * WIN_SZ;
constexpr size_t OFF_WKV = OFF_W;
constexpr size_t WKV_SZ = (size_t)4224 * (1024 + WPAD) * 2;
constexpr size_t OFF_WQ0 = OFF_WKV + WKV_SZ;
constexpr size_t OFF_WR0 = OFF_WQ0 + W4M;
constexpr size_t OFF_WQ1 = OFF_WR0 + W4M;
constexpr size_t OFF_WR1 = OFF_WQ1 + W4M;
static_assert(OFF_WR1 + W4M <= OFF_WOUT, "fox weights must fit in gla w_in region");
constexpr size_t OFF_FWOUT = OFF_WOUT + 2 * W4M;
constexpr size_t OFF_SMALL = OFF_FWOUT + 2 * W4M;
constexpr size_t OFF_HMETA = OFF_SMALL;
constexpr size_t OFF_SSQ = OFF_HMETA + 128 * 4096;
constexpr size_t OFF_GLOW = OFF_SSQ + (size_t)TT * 32 * 4;
constexpr size_t OFF_EB = OFF_GLOW + (size_t)TT * 16 * 4;
constexpr size_t OFF_SSQO = OFF_EB + (size_t)8 * 65 * 1024 * 4;
constexpr size_t OFF_FLOG = OFF_SSQO + (size_t)TT * 64 * 4;
constexpr size_t OFF_CUM = OFF_FLOG + (size_t)TT * 16 * 4;
constexpr size_t OFF_BAR = OFF_CUM + (size_t)128 * 2112 * 4;
constexpr size_t OFF_KMAX = OFF_BAR + 3456 * 4;
constexpr size_t BAR_BYTES = 3456 * 4 + 512;
constexpr size_t OFF_KMAXP = OFF_BAR + BAR_BYTES;
constexpr size_t WS_END = OFF_KMAXP + (size_t)129 * 16 * 8 * 4;
static_assert(WS_END <= 268435456, "workspace");

constexpr int SMEM_BYTES = 76800;
constexpr int PROBE_PHASE = -1;

struct Params {
  const float *x, *meta, *norm_g, *gla_w_in, *gla_w_gate_up, *gla_b_gate, *gla_hn_g, *gla_w_out;
  const float *kv_norm_g, *fox_w_kv, *fox_b_forget, *fox_w_in, *fox_w_out, *final_g;
  float* out;
  char* ws;
};

DI u32 pack2(float a, float b) { f32x2 v = {a, b}; bf16x2_t r = __builtin_convertvector(v, bf16x2_t); return __builtin_bit_cast(u32, r); }
DI u16 f2bf(float x) { __bf16 b = (__bf16)x; return __builtin_bit_cast(u16, b); }
DI float bf2f(u32 b) { return __uint_as_float(b << 16); }
DI float bflo(u32 v) { return __uint_as_float(v << 16); }
DI float bfhi(u32 v) { return __uint_as_float(v & 0xffff0000u); }
DI int crow(int x, int h) { return (x & 3) + 8 * (x >> 2) + 4 * h; }
template <int S> DI bf16x8 pack8(const f32x16& x) {
  u32x4 p;
  p[0] = pack2(x[8 * S + 0], x[8 * S + 1]); p[1] = pack2(x[8 * S + 2], x[8 * S + 3]);
  p[2] = pack2(x[8 * S + 4], x[8 * S + 5]); p[3] = pack2(x[8 * S + 6], x[8 * S + 7]);
  return __builtin_bit_cast(bf16x8, p);
}
DI s16x4 tr_read(const char* lds_ptr) {
  return __builtin_amdgcn_ds_read_tr16_b64_v4i16((s16x4 __attribute__((address_space(3)))*)(lds_ptr));
}
DI bf16x8 cat8(s16x4 lo, s16x4 hi) { return __builtin_shufflevector(lo, hi, 0, 1, 2, 3, 4, 5, 6, 7); }
DI float dpp_x1(float v) { return __int_as_float(__builtin_amdgcn_update_dpp(0, __float_as_int(v), 0xB1, 0xF, 0xF, true)); }
DI float dpp_x2(float v) { return __int_as_float(__builtin_amdgcn_update_dpp(0, __float_as_int(v), 0x4E, 0xF, 0xF, true)); }
DI float dpp_m8(float v) { return __int_as_float(__builtin_amdgcn_update_dpp(0, __float_as_int(v), 0x141, 0xF, 0xF, true)); }
DI float silu(float x) { return x / (1.f + __expf(-x)); }
DI float logsig(float x) { return fminf(x, 0.f) - log1pf(expf(-fabsf(x))); }
DI float logsig_fast(float x) { return fminf(x, 0.f) - __logf(1.f + __expf(-fabsf(x))); }

DI u16* hrow(const Params& p, int t) {
  const int b = t / LL, pp = t - b * LL;
  const bool meta = pp < 16;
  char* base = meta ? p.ws + OFF_HMETA : (char*)p.out;
  const int idx = meta ? b * 16 + pp : b * 2048 + pp - 16;
  return (u16*)(base + (size_t)idx * 4096);
}

struct ConvJob { const float* src; const float* g; u16* dst; int ldsrc, gmask, K, cmode, coff, nvalid, ntn; };
DI int conv_srccol(const ConvJob& j, int n) {
  if (j.cmode == 1) { if (n < 4096) return n; if (n < 6144) return n + 16; if (n < 6160) return n - 2048; return -1; }
  return n < j.nvalid ? j.coff + n : -1;
}
DI void conv_unit(const ConvJob& j, int unit, float* sm, int tid) {
  const int nt = unit % j.ntn, kt = unit / j.ntn;
  const int n0 = nt * 64, k0 = kt * 64;
  __syncthreads();
  {
    const int nn = tid & 63; const int sc = conv_srccol(j, n0 + nn);
    float vv[16], gg[16];
#pragma unroll
    for (int i = 0; i < 16; ++i) {
      const int k = k0 + i * 4 + (tid >> 6);
      vv[i] = sc >= 0 ? j.src[(size_t)k * j.ldsrc + sc] : 0.f;
      gg[i] = j.g ? j.g[k & j.gmask] : 1.f;
    }
#pragma unroll
    for (int i = 0; i < 16; ++i) sm[(i * 4 + (tid >> 6)) * 65 + nn] = vv[i] * gg[i];
  }
  __syncthreads();
  {
    const int kk = tid & 63;
#pragma unroll
    for (int i = 0; i < 16; ++i) { const int n = i * 4 + (tid >> 6); j.dst[(size_t)(n0 + n) * (j.K + WPAD) + k0 + kk] = f2bf(sm[kk * 65 + n]); }
  }
}
constexpr int CONV_GLA_UNITS = 2 * 1568 + 2 * 512;
constexpr int CONV_FOX_UNITS = 1056 + 4 * 512 + 2 * 512;
DI void conv_gla(const Params& p, int u, float* sm, int tid) {
  ConvJob j;
  if (u < 3136) {
    const int l = u / 1568; u -= l * 1568;
    j.src = p.gla_w_in + (size_t)l * 1024 * 6160; j.ldsrc = 6160; j.g = p.norm_g + l * 1024; j.gmask = 1023;
    j.dst = (u16*)(p.ws + OFF_WIN + l * WIN_SZ); j.K = 1024; j.cmode = 1; j.coff = 0; j.nvalid = 0; j.ntn = 98;
  } else {
    u -= 3136; const int l = u / 512; u -= l * 512;
    j.src = p.gla_w_out + (size_t)l * 2048 * 1024; j.ldsrc = 1024; j.g = p.gla_hn_g + l * 512; j.gmask = 511;
    j.dst = (u16*)(p.ws + OFF_WOUT + l * W4M); j.K = 2048; j.cmode = 0; j.coff = 0; j.nvalid = 1024; j.ntn = 16;
  }
  conv_unit(j, u, sm, tid);
}
DI void conv_fox(const Params& p, int u, float* sm, int tid) {
  ConvJob j; j.cmode = 0;
  if (u < 1056) {
    j.src = p.fox_w_kv; j.ldsrc = 4112; j.g = p.kv_norm_g; j.gmask = 1023; j.dst = (u16*)(p.ws + OFF_WKV); j.K = 1024;
    j.coff = 0; j.nvalid = 4112; j.ntn = 66;
  } else if (u < 1056 + 2048) {
    u -= 1056; const int m = u / 512; u -= m * 512;
    const int l = m >> 1;
    j.src = p.fox_w_in + (size_t)l * 1024 * 4096; j.ldsrc = 4096; j.g = p.norm_g + (2 + l) * 1024; j.gmask = 1023;
    j.dst = (u16*)(p.ws + OFF_WQ0 + (size_t)m * W4M); j.K = 1024; j.coff = (m & 1) * 2048; j.nvalid = 2048; j.ntn = 32;
  } else {
    u -= 1056 + 2048; const int l = u / 512; u -= l * 512;
    j.src = p.fox_w_out + (size_t)l * 2048 * 1024; j.ldsrc = 1024; j.g = nullptr; j.gmask = 0;
    j.dst = (u16*)(p.ws + OFF_FWOUT + l * W4M); j.K = 2048; j.coff = 0; j.nvalid = 1024; j.ntn = 16;
  }
  conv_unit(j, u, sm, tid);
}

DI void h0_unit(const Params& p, int unit, int tid) {
  const int w = tid >> 6, l = tid & 63; const int t = unit * 4 + w; const int b = t / LL, pp = t - b * LL;
  const float* src = pp < 16 ? p.meta + pp * 1024 : p.x + ((size_t)b * 2048 + pp - 16) * 1024;
  u16* hr = hrow(p, t);
  float* ssq = (float*)(p.ws + OFF_SSQ) + (size_t)t * 32;
  float4 vin[4];
#pragma unroll
  for (int i = 0; i < 4; ++i) vin[i] = *(const float4*)(src + 4 * l + 256 * i);
#pragma unroll
  for (int i = 0; i < 4; ++i) {
    const int c = 4 * l + 256 * i; const float4 v = vin[i];
    u32x2 hi, lo;
    hi[0] = pack2(v.x, v.y); hi[1] = pack2(v.z, v.w);
    lo[0] = pack2(v.x - bflo(hi[0]), v.y - bfhi(hi[0])); lo[1] = pack2(v.z - bflo(hi[1]), v.w - bfhi(hi[1]));
    *(u32x2*)(hr + c) = hi; *(u32x2*)(hr + 1024 + c) = lo;
    float s = v.x * v.x + v.y * v.y + v.z * v.z + v.w * v.w;
    s += dpp_x1(s); s += dpp_x2(s); s += dpp_m8(s);
    if ((l & 7) == 0) ssq[8 * i + (l >> 3)] = s;
  }
}

enum { G_GLAIN = 0, G_GLAOUT, G_KVQ, G_Q1, G_RGATE, G_FOXOUT };

template <bool FOLD, int SUB, class Pre>
DI void gemm_main(const u16* a0, const u16* a1, const u16* a2, const u16* a3, const u16* b0, size_t bstr, int nk, int rot,
                  char* smem, const float* sStat, f32x16 (&acc)[SUB][SUB], f32x16 (&tot)[SUB][SUB], int tid, Pre&& pre) {
  const int w = tid >> 6, lane = tid & 63, r = lane & 31, h = lane >> 5, wr = w >> 1, wc = w & 1;
  constexpr int NCH = 2 * SUB;
  typedef __attribute__((address_space(3))) void* lds_ptr_t;
  auto issue = [&](int kt) {
    const int ko = ((kt + rot) & (nk - 1)) * 64;
    char* st = smem + (kt & 1) * 32768 + tid * 16;
    __builtin_amdgcn_global_load_lds((const u32*)(a0 + ko), (lds_ptr_t)(st), 16, 0, 0);
    __builtin_amdgcn_global_load_lds((const u32*)(a1 + ko), (lds_ptr_t)(st + 4096), 16, 0, 0);
    if (SUB == 2) {
      __builtin_amdgcn_global_load_lds((const u32*)(a2 + ko), (lds_ptr_t)(st + 8192), 16, 0, 0);
      __builtin_amdgcn_global_load_lds((const u32*)(a3 + ko), (lds_ptr_t)(st + 12288), 16, 0, 0);
    }
#pragma unroll
    for (int i = 0; i < NCH; ++i)
      __builtin_amdgcn_global_load_lds((const u32*)(b0 + i * bstr + ko), (lds_ptr_t)(st + 16384 + i * 4096), 16, 0, 0);
  };
  const int fr = (r >> 1) & 7;
  int aofs[4], bofs[4];
#pragma unroll
  for (int ks = 0; ks < 4; ++ks) {
    aofs[ks] = (32 * SUB * wr + r) * 128 + (((2 * ks + h) ^ fr) * 16);
    bofs[ks] = 16384 + (32 * SUB * wc + r) * 128 + (((2 * ks + h) ^ fr) * 16);
  }
  issue(0); issue(1);
  pre();
  asm volatile("s_waitcnt vmcnt(0)" ::: "memory");
  __syncthreads();
  for (int kt = 0; kt < nk; ++kt) {
    if (kt > 0 && kt + 1 < nk) issue(kt + 1);
    const char* cur = smem + (kt & 1) * 32768;
#pragma unroll
    for (int ks = 0; ks < 4; ++ks) {
      bf16x8 af[SUB], bf[SUB];
#pragma unroll
      for (int mi = 0; mi < SUB; ++mi) af[mi] = *(const bf16x8*)(cur + aofs[ks] + mi * 32 * 128);
#pragma unroll
      for (int ni = 0; ni < SUB; ++ni) bf[ni] = *(const bf16x8*)(cur + bofs[ks] + ni * 32 * 128);
#pragma unroll
      for (int mi = 0; mi < SUB; ++mi)
#pragma unroll
        for (int ni = 0; ni < SUB; ++ni) acc[mi][ni] = MFMA(af[mi], bf[ni], acc[mi][ni]);
    }
    if (FOLD && (kt & 7) == 7) {
      const int head = ((kt + rot) & (nk - 1)) >> 3;
#pragma unroll
      for (int mi = 0; mi < SUB; ++mi)
#pragma unroll
        for (int x = 0; x < 16; ++x) {
          const float sc = sStat[(32 * SUB * wr + 32 * mi + crow(x, h)) * 4 + head];
#pragma unroll
          for (int ni = 0; ni < SUB; ++ni) { tot[mi][ni][x] += sc * acc[mi][ni][x]; acc[mi][ni][x] = 0.f; }
        }
    }
    asm volatile("s_waitcnt vmcnt(0)" ::: "memory");
    __syncthreads();
  }
}

template <int KIND, int SUB>
DI void gemm_tile(const Params& p, int layer, int rb, int cb, int sr, int sc, char* smem, int tid, int dry) {
  const int w = tid >> 6, lane = tid & 63, r = lane & 31, h = lane >> 5, wr = w >> 1, wc = w & 1;
  const int r0 = tid >> 3, kc = tid & 7;
  float* sStat = (float*)(smem + 73728);
  constexpr bool HSRC = (KIND == G_GLAIN || KIND == G_KVQ || KIND == G_Q1 || KIND == G_RGATE);
  constexpr int K = HSRC ? 1024 : 2048;
  constexpr int R = 64 * SUB;
  const int row0 = rb * 128 + (SUB == 1 ? 64 * sr : 0);
  const int col0 = SUB == 1 ? 64 * sc : 0;
  __syncthreads();
  const u16 *a0, *a1, *a2, *a3;
  const int kcs = (kc ^ ((r0 >> 1) & 7)) * 8;
  if (HSRC) {
    a0 = hrow(p, row0 + r0) + kcs; a1 = hrow(p, row0 + r0 + 32) + kcs;
    a2 = SUB == 2 ? hrow(p, row0 + r0 + 64) + kcs : a0; a3 = SUB == 2 ? hrow(p, row0 + r0 + 96) + kcs : a0;
  } else {
    const u16* base = (const u16*)(p.ws + (KIND == G_GLAOUT ? OFF_S1 : OFF_S2)) + (size_t)(row0 + r0) * 2048 + kcs;
    a0 = base; a1 = base + (size_t)32 * 2048; a2 = base + (size_t)64 * 2048; a3 = base + (size_t)96 * 2048;
  }
  const u16* bt;
  if (KIND == G_GLAIN) bt = (const u16*)(p.ws + OFF_WIN + layer * WIN_SZ) + (size_t)cb * 128 * (1024 + WPAD);
  else if (KIND == G_GLAOUT) bt = (const u16*)(p.ws + OFF_WOUT + layer * W4M) + (size_t)cb * 128 * (2048 + WPAD);
  else if (KIND == G_KVQ) bt = cb < 33 ? (const u16*)(p.ws + OFF_WKV) + (size_t)cb * 128 * (1024 + WPAD) : (const u16*)(p.ws + OFF_WQ0) + (size_t)(cb - 33) * 128 * (1024 + WPAD);
  else if (KIND == G_Q1) bt = (const u16*)(p.ws + OFF_WQ1) + (size_t)cb * 128 * (1024 + WPAD);
  else if (KIND == G_RGATE) bt = (const u16*)(p.ws + (layer ? OFF_WR1 : OFF_WR0)) + (size_t)cb * 128 * (1024 + WPAD);
  else bt = (const u16*)(p.ws + OFF_FWOUT + layer * W4M) + (size_t)cb * 128 * (2048 + WPAD);
  const u16* b0 = bt + (size_t)(col0 + r0) * (K + WPAD) + kcs;

  f32x16 acc[SUB][SUB], tot[SUB][SUB];
#pragma unroll
  for (int mi = 0; mi < SUB; ++mi)
#pragma unroll
    for (int ni = 0; ni < SUB; ++ni)
#pragma unroll
      for (int x = 0; x < 16; ++x) { acc[mi][ni][x] = 0.f; tot[mi][ni][x] = 0.f; }
  auto stats = [&]() {
  if (HSRC) {
    if (tid < R) {
      const float4* s4 = (const float4*)((const float*)(p.ws + OFF_SSQ) + (size_t)(row0 + tid) * 32);
      float s = 0.f;
#pragma unroll
      for (int i = 0; i < 8; ++i) { const float4 v = s4[i]; s += v.x + v.y + v.z + v.w; }
      sStat[tid] = rsqrtf(s * (1.f / 1024.f) + 1e-6f);
    }
  } else if (KIND == G_GLAOUT) {
#pragma unroll
    for (int e = 0; e < 2; ++e) {
      const int idx = tid * 2 + e;
      if (idx < R * 4) {
        const float4* s4 = (const float4*)((const float*)(p.ws + OFF_SSQO) + ((size_t)row0 * 4 + idx) * 16);
        float s = 0.f;
#pragma unroll
        for (int i = 0; i < 4; ++i) { const float4 v = s4[i]; s += v.x + v.y + v.z + v.w; }
        sStat[idx] = rsqrtf(s * (1.f / 512.f) + 1e-6f);
      }
    }
  }
  };
  const int rot = (KIND == G_GLAOUT) ? 8 * ((rb + cb + sr + sc) & 3) : ((rb * 5 + cb * 3 + sr * 7 + sc * 2) & (K / 64 - 1));
  gemm_main<KIND == G_GLAOUT, SUB>(a0, a1, a2, a3, b0, (size_t)32 * (K + WPAD), K / 64, rot, smem, sStat, acc, tot, tid, stats);

  constexpr int CP = R + 4;
  constexpr int NCC = R / 8;
  constexpr int RPP = 256 / NCC;
  constexpr int NPASS = R / RPP;
  if (KIND == G_GLAOUT || KIND == G_FOXOUT) {
    float* ssq = (float*)(p.ws + OFF_SSQ);
    float* sC = (float*)smem;
#pragma unroll
    for (int mi = 0; mi < SUB; ++mi)
#pragma unroll
      for (int x = 0; x < 16; ++x)
#pragma unroll
        for (int ni = 0; ni < SUB; ++ni)
          sC[(32 * SUB * wr + 32 * mi + crow(x, h)) * CP + 32 * SUB * wc + 32 * ni + r] = (KIND == G_GLAOUT) ? tot[mi][ni][x] : acc[mi][ni][x];
    __syncthreads();
    const int cc = tid % NCC, rq = tid / NCC;
    u32x4 vhi[NPASS], vlo[NPASS];
#pragma unroll
    for (int j = 0; j < NPASS; ++j) {
      const u16* hr = hrow(p, row0 + rq + RPP * j) + cb * 128 + col0 + cc * 8;
      vhi[j] = *(const u32x4*)hr; vlo[j] = *(const u32x4*)(hr + 1024);
    }
#pragma unroll
    for (int j = 0; j < NPASS; ++j) {
      const int row = rq + RPP * j; const int t = row0 + row;
      u16* hr = hrow(p, t) + cb * 128 + col0 + cc * 8;
      const float4 c0 = *(const float4*)(sC + row * CP + cc * 8), c1 = *(const float4*)(sC + row * CP + cc * 8 + 4);
      const float cv[8] = {c0.x, c0.y, c0.z, c0.w, c1.x, c1.y, c1.z, c1.w};
      u32x4 nh, nl; float sq = 0.f;
#pragma unroll
      for (int i = 0; i < 4; ++i) {
        const float h0 = bflo(vhi[j][i]) + bflo(vlo[j][i]) + cv[2 * i], h1 = bfhi(vhi[j][i]) + bfhi(vlo[j][i]) + cv[2 * i + 1];
        nh[i] = pack2(h0, h1); nl[i] = pack2(h0 - bflo(nh[i]), h1 - bfhi(nh[i]));
        sq += h0 * h0 + h1 * h1;
      }
      sq += dpp_x1(sq); sq += dpp_x2(sq);
      if (!dry) {
        *(u32x4*)hr = nh; *(u32x4*)(hr + 1024) = nl;
        if ((cc & 3) == 0) ssq[(size_t)t * 32 + ((cb * 128 + col0 + cc * 8) >> 5)] = sq;
      }
    }
  } else {
    u16* s0 = (u16*)(p.ws + OFF_S0); u16* s1 = (u16*)(p.ws + OFF_S1); u16* s2 = (u16*)(p.ws + OFF_S2);
    u16* dst = s2 + cb * 128; float scale = 1.f; int mode = 0;
    if (KIND == G_GLAIN) {
      if (cb < 16) { dst = s0 + cb * 128; scale = cb < 8 ? 0.0625f : 1.f; }
      else if (cb < 32) dst = s1 + (cb - 16) * 128;
      else if (cb < 48) dst = s2 + (cb - 32) * 128;
      else mode = 1;
    } else if (KIND == G_KVQ) {
      if (cb < 16) dst = s0 + cb * 128;
      else if (cb < 32) dst = s1 + (cb - 16) * 128;
      else if (cb == 32) mode = 2;
      else { dst = s2 + (cb - 33) * 128; scale = 0.08838834764831845f; }
    } else if (KIND == G_Q1) { scale = 0.08838834764831845f; }
    else mode = 3;
    float* sC = (float*)smem;
#pragma unroll
    for (int mi = 0; mi < SUB; ++mi)
#pragma unroll
      for (int x = 0; x < 16; ++x) {
        const int rl = 32 * SUB * wr + 32 * mi + crow(x, h);
        const float rs = sStat[rl] * scale;
#pragma unroll
        for (int ni = 0; ni < SUB; ++ni) sC[rl * CP + 32 * SUB * wc + 32 * ni + r] = acc[mi][ni][x] * rs;
      }
    __syncthreads();
    if (mode == 0 || mode == 3) {
      const int cc = tid % NCC, rq = tid / NCC;
      u16* d0 = dst + ((size_t)row0 + rq) * 2048 + col0 + cc * 8;
      u32x4 vo[NPASS];
      float kmx0 = 0.f, kmx1 = 0.f;
      if (KIND == G_RGATE) {
#pragma unroll
        for (int j = 0; j < NPASS; ++j) vo[j] = *(const u32x4*)(d0 + (size_t)RPP * j * 2048);
      }
#pragma unroll
      for (int j = 0; j < NPASS; ++j) {
        const int row = rq + RPP * j;
        const float4 c0 = *(const float4*)(sC + row * CP + cc * 8), c1 = *(const float4*)(sC + row * CP + cc * 8 + 4);
        const float cv[8] = {c0.x, c0.y, c0.z, c0.w, c1.x, c1.y, c1.z, c1.w};
        u32x4 nv;
#pragma unroll
        for (int i = 0; i < 4; ++i) {
          if (KIND == G_RGATE) nv[i] = pack2(bflo(vo[j][i]) * silu(cv[2 * i]), bfhi(vo[j][i]) * silu(cv[2 * i + 1]));
          else nv[i] = pack2(cv[2 * i], cv[2 * i + 1]);
        }
        if (!(KIND == G_RGATE && dry)) *(u32x4*)(d0 + (size_t)RPP * j * 2048) = nv;
        if (KIND == G_KVQ && cb < 16) {
          float s = 0.f;
#pragma unroll
          for (int i = 0; i < 4; ++i) { const float x0 = bflo(nv[i]), x1 = bfhi(nv[i]); s += x0 * x0 + x1 * x1; }
          s += __shfl_xor(s, 1); s += __shfl_xor(s, 2); s += __shfl_xor(s, 4);
          if (NCC == 16) s += __shfl_xor(s, 8);
          if (SUB == 1) {
            if (cc == 0) atomicMax((u32*)(p.ws + OFF_KMAX) + ((row0 + row) / LL) * 16 + cb, __float_as_uint(2.f * s));
          } else if ((row0 + row) / LL == row0 / LL) kmx0 = fmaxf(kmx0, s); else kmx1 = fmaxf(kmx1, s);
        }
      }
      if (KIND == G_KVQ && SUB == 2 && cb < 16) {
        kmx0 = fmaxf(kmx0, __shfl_xor(kmx0, 16)); kmx0 = fmaxf(kmx0, __shfl_xor(kmx0, 32));
        kmx1 = fmaxf(kmx1, __shfl_xor(kmx1, 16)); kmx1 = fmaxf(kmx1, __shfl_xor(kmx1, 32));
        if (lane == 0) { float* kp = (float*)(p.ws + OFF_KMAXP) + ((size_t)(rb * 16 + cb) * 8 + w * 2); kp[0] = kmx0; kp[1] = kmx1; }
      }
    } else if (col0 == 0 && tid < R) {
      float* fdst = (float*)(p.ws + (mode == 1 ? OFF_GLOW : OFF_FLOG)) + ((size_t)row0 + tid) * 16;
#pragma unroll
      for (int q = 0; q < 4; ++q) {
        float4 v = *(const float4*)(sC + tid * CP + 4 * q);
        if (mode == 2) {
          const float4 bq = *(const float4*)(p.fox_b_forget + 4 * q);
          v.x = logsig(v.x + bq.x); v.y = logsig(v.y + bq.y); v.z = logsig(v.z + bq.z); v.w = logsig(v.w + bq.w);
        }
        *(float4*)(fdst + 4 * q) = v;
      }
    }
  }
}

DI void prep_unit(const Params& p, int layer, int u, int tid, int dry, char* smem) {
  const int half = u & 1, bc = (u & 1023) >> 1;
  const int c = u < 1024 ? 1 + (bc & 63) : 0, b = u < 1024 ? bc >> 6 : bc;
  const int col = half * 512 + tid * 2;
  const float* Wg = p.gla_w_gate_up + (size_t)layer * 16 * 1024; const float* bg = p.gla_b_gate + layer * 1024;
  u16* qk = (u16*)(p.ws + OFF_S0); const float* glow = (const float*)(p.ws + OFF_GLOW);
  float* sG = (float*)smem;
  const int pos0 = 32 * c - 16;
  __syncthreads();
  if (tid < 128) {
    const int i = tid >> 2; const int pp = pos0 + i; float4 v = {0.f, 0.f, 0.f, 0.f};
    if (pp >= 0) v = *(const float4*)(glow + ((size_t)b * LL + pp) * 16 + (tid & 3) * 4);
    *(float4*)(sG + i * 16 + (tid & 3) * 4) = v;
  }
  float w0[16], w1[16];
#pragma unroll
  for (int r = 0; r < 16; ++r) { const float2 v = *(const float2*)(Wg + r * 1024 + col); w0[r] = v.x; w1[r] = v.y; }
  const float bb0 = bg[col], bb1 = bg[col + 1];
  u32 qv[32], kv[32];
#pragma unroll
  for (int i = 0; i < 32; ++i) {
    const int pp = pos0 + i; qv[i] = 0u; kv[i] = 0u;
    if (pp >= 0) { const u16* q = qk + ((size_t)b * LL + pp) * 2048 + col; qv[i] = *(const u32*)q; kv[i] = *(const u32*)(q + 1024); }
  }
  __syncthreads();
  float c0 = 0.f, c1 = 0.f;
#pragma unroll
  for (int i = 0; i < 32; ++i) {
    const int pp = pos0 + i;
    if (pp >= 0) {
      float x0 = bb0, x1 = bb1;
#pragma unroll
      for (int r4 = 0; r4 < 4; ++r4) {
        const float4 g = *(const float4*)(sG + i * 16 + r4 * 4);
        x0 += g.x * w0[4 * r4] + g.y * w0[4 * r4 + 1] + g.z * w0[4 * r4 + 2] + g.w * w0[4 * r4 + 3];
        x1 += g.x * w1[4 * r4] + g.y * w1[4 * r4 + 1] + g.z * w1[4 * r4 + 2] + g.w * w1[4 * r4 + 3];
      }
      c0 += logsig_fast(x0) * 0.0625f; c1 += logsig_fast(x1) * 0.0625f;
      const float e0 = __expf(c0), e1 = __expf(c1), f0 = __expf(-c0), f1 = __expf(-c1);
      u16* q = qk + ((size_t)b * LL + pp) * 2048 + col;
      const u32 nq = pack2(bflo(qv[i]) * e0, bfhi(qv[i]) * e1), nk = pack2(bflo(kv[i]) * f0, bfhi(kv[i]) * f1);
      if (!dry) { *(u32*)q = nq; *(u32*)(q + 1024) = nk; }
    }
  }
  float2 ev; ev.x = __expf(c0); ev.y = __expf(c1);
  *(float2*)((float*)(p.ws + OFF_EB) + ((size_t)b * 65 + c) * 1024 + col) = ev;
}

struct ScanRegs { u32x4 pq[4], pk[4], pv, pe; u32x2 pr; };
DI void scan_unit(const Params& p, int u, char* smem, int tid, int dry) {
  const int w = tid >> 6, lane = tid & 63, r = lane & 31, h = lane >> 5;
  const int i16 = lane & 15, q4 = i16 >> 2, p4 = i16 & 3, blk = (lane >> 4) & 1;
  const int slice = u & 15, head = (u >> 4) & 3, b = u >> 6;
  char* sQ = smem; char* sK = smem + 16896; char* sV = smem + 16896 + 18432;
  float* sEb = (float*)(smem + 16896 + 18432 + 2048); float* sRed = (float*)(smem + 16896 + 18432 + 2048 + 1024);
  const u16* qk = (const u16*)(p.ws + OFF_S0); u16* vo = (u16*)(p.ws + OFF_S1); const u16* rr = (const u16*)(p.ws + OFF_S2);
  const float* eb = (const float*)(p.ws + OFF_EB) + (size_t)b * 65 * 1024 + head * 256;
  float* ssqo = (float*)(p.ws + OFF_SSQO);
  const int dw = 64 * w;
  f32x16 S0, S1;
#pragma unroll
  for (int x = 0; x < 16; ++x) { S0[x] = 0.f; S1[x] = 0.f; }
  const u32x4 z4 = {0u, 0u, 0u, 0u};
  auto load = [&](int c, ScanRegs& R) {
    const int pos0 = 32 * c - 16;
#pragma unroll
    for (int i = 0; i < 4; ++i) {
      const int row = (tid >> 5) + 8 * i; const int pp = pos0 + row;
      if (pp >= 0) {
        const u16* src = qk + ((size_t)b * LL + pp) * 2048 + head * 256 + (tid & 31) * 8;
        R.pq[i] = *(const u32x4*)src; R.pk[i] = *(const u32x4*)(src + 1024);
      } else { R.pq[i] = z4; R.pk[i] = z4; }
    }
    R.pv = z4;
    if (tid < 128) { const int pp = pos0 + (tid >> 2); if (pp >= 0) R.pv = *(const u32x4*)(vo + ((size_t)b * LL + pp) * 2048 + head * 512 + slice * 32 + (tid & 3) * 8); }
    R.pe = z4;
    if (tid < 64) R.pe = *(const u32x4*)(eb + (size_t)c * 1024 + tid * 4);
    { const int pp = pos0 + (tid >> 3); R.pr[0] = 0u; R.pr[1] = 0u;
      if (pp >= 0) R.pr = *(const u32x2*)(rr + ((size_t)b * LL + pp) * 2048 + head * 512 + slice * 32 + (tid & 7) * 4); }
  };
  auto step = [&](int c, ScanRegs& R) {
#pragma unroll
    for (int i = 0; i < 4; ++i) {
      const int row = (tid >> 5) + 8 * i;
      *(u32x4*)(sQ + row * 528 + (tid & 31) * 16) = R.pq[i]; *(u32x4*)(sK + row * 576 + (tid & 31) * 16) = R.pk[i];
    }
    if (tid < 128) *(u32x4*)(sV + (tid >> 2) * 64 + (tid & 3) * 16) = R.pv;
    if (tid < 64) *(u32x4*)(sEb + tid * 4) = R.pe;
    const u32x2 rcur = R.pr;
    __syncthreads();
    if (c + 1 < 65) load(c + 1, R);
    f32x16 pt;
#pragma unroll
    for (int x = 0; x < 16; ++x) pt[x] = 0.f;
#pragma unroll
    for (int s = 0; s < 4; ++s) {
      const bf16x8 A = *(const bf16x8*)(sK + r * 576 + (dw + 16 * s + 8 * h) * 2);
      const bf16x8 B = *(const bf16x8*)(sQ + r * 528 + (dw + 16 * s + 8 * h) * 2);
      pt = MFMA(A, B, pt);
    }
#pragma unroll
    for (int x = 0; x < 16; ++x) if (crow(x, h) > r) pt[x] = 0.f;
    const bf16x8 pb0 = pack8<0>(pt), pb1 = pack8<1>(pt);
    f32x16 ot;
#pragma unroll
    for (int x = 0; x < 16; ++x) ot[x] = 0.f;
    {
      const char* vb = sV + (4 * h + q4) * 64 + (16 * blk + 4 * p4) * 2;
      const bf16x8 A0 = cat8(tr_read(vb), tr_read(vb + 8 * 64));
      const bf16x8 A1 = cat8(tr_read(vb + 16 * 64), tr_read(vb + 24 * 64));
      ot = MFMA(A0, pb0, ot); ot = MFMA(A1, pb1, ot);
    }
    {
      const char* qb = sQ + r * 528 + (dw + 4 * h) * 2;
      const bf16x8 B00 = cat8(*(const s16x4*)(qb), *(const s16x4*)(qb + 16));
      const bf16x8 B01 = cat8(*(const s16x4*)(qb + 32), *(const s16x4*)(qb + 48));
      const bf16x8 B10 = cat8(*(const s16x4*)(qb + 64), *(const s16x4*)(qb + 80));
      const bf16x8 B11 = cat8(*(const s16x4*)(qb + 96), *(const s16x4*)(qb + 112));
      ot = MFMA(pack8<0>(S0), B00, ot); ot = MFMA(pack8<1>(S0), B01, ot);
      ot = MFMA(pack8<0>(S1), B10, ot); ot = MFMA(pack8<1>(S1), B11, ot);
    }
    {
      const char* vb = sV + (8 * h + q4) * 64 + (16 * blk + 4 * p4) * 2;
      const bf16x8 Bv0 = cat8(tr_read(vb), tr_read(vb + 4 * 64));
      const bf16x8 Bv1 = cat8(tr_read(vb + 16 * 64), tr_read(vb + 20 * 64));
      const char* kb = sK + (8 * h + q4) * 576 + (dw + 16 * blk + 4 * p4) * 2;
      const bf16x8 A00 = cat8(tr_read(kb), tr_read(kb + 4 * 576));
      const bf16x8 A01 = cat8(tr_read(kb + 16 * 576), tr_read(kb + 20 * 576));
      const bf16x8 A10 = cat8(tr_read(kb + 64), tr_read(kb + 64 + 4 * 576));
      const bf16x8 A11 = cat8(tr_read(kb + 64 + 16 * 576), tr_read(kb + 64 + 20 * 576));
      S0 = MFMA(A00, Bv0, S0); S0 = MFMA(A01, Bv1, S0);
      S1 = MFMA(A10, Bv0, S1); S1 = MFMA(A11, Bv1, S1);
#pragma unroll
      for (int x = 0; x < 16; ++x) { S0[x] *= sEb[dw + crow(x, h)]; S1[x] *= sEb[dw + 32 + crow(x, h)]; }
    }
#pragma unroll
    for (int x = 0; x < 16; ++x) sRed[(w * 32 + crow(x, h)) * 33 + r] = ot[x];
    __syncthreads();
    {
      const int tok = tid >> 3, dvq = (tid & 7) * 4;
      const int pp = 32 * c - 16 + tok;
      float o[4];
#pragma unroll
      for (int e = 0; e < 4; ++e) o[e] = sRed[(dvq + e) * 33 + tok] + sRed[(32 + dvq + e) * 33 + tok] + sRed[(64 + dvq + e) * 33 + tok] + sRed[(96 + dvq + e) * 33 + tok];
      float ss = o[0] * o[0] + o[1] * o[1] + o[2] * o[2] + o[3] * o[3];
      ss += dpp_x1(ss); ss += dpp_x2(ss); ss += dpp_m8(ss);
      if (pp >= 0 && !dry) {
        const size_t t = (size_t)b * LL + pp;
        if ((tid & 7) == 0) ssqo[(t * 4 + head) * 16 + slice] = ss;
        u32x2 ov;
        ov[0] = pack2(o[0] * silu(bflo(rcur[0])), o[1] * silu(bfhi(rcur[0])));
        ov[1] = pack2(o[2] * silu(bflo(rcur[1])), o[3] * silu(bfhi(rcur[1])));
        *(u32x2*)(vo + t * 2048 + head * 512 + slice * 32 + dvq) = ov;
      }
    }
    __syncthreads();
  };
  ScanRegs RA;
  __syncthreads();
  load(0, RA);
  for (int c = 0; c < 65; ++c) step(c, RA);
}

DI void cumsum_unit(const Params& p, int bh, int tid, char* smem) {
  const int w = tid >> 6, lane = tid & 63; const int b = bh >> 4, hd = bh & 15;
  const float* flog = (const float*)(p.ws + OFF_FLOG); float* cum = (float*)(p.ws + OFF_CUM) + (size_t)bh * 2112;
  float* sT = (float*)smem;
  float v[9];
#pragma unroll
  for (int e = 0; e < 9; ++e) { const int pp = 9 * tid + e, pos = pp - 48; v[e] = (pos >= 0 && pp < 2112) ? flog[((size_t)b * LL + pos) * 16 + hd] : 0.f; }
#pragma unroll
  for (int e = 1; e < 9; ++e) v[e] += v[e - 1];
  float tot = v[8];
#pragma unroll
  for (int d = 1; d < 64; d <<= 1) { const float n = __shfl_up(tot, d); if (lane >= d) tot += n; }
  __syncthreads();
  if (lane == 63) sT[w] = tot;
  __syncthreads();
  float base = tot - v[8];
  for (int i = 0; i < w; ++i) base += sT[i];
#pragma unroll
  for (int e = 0; e < 9; ++e) { const int pp = 9 * tid + e; if (pp < 2112) cum[pp] = v[e] + base; }
}

DI void attn_unit(const Params& p, int qb, int bh, char* smem, int tid, int dry) {
  const int w = tid >> 6, lane = tid & 63, r = lane & 31, h = lane >> 5;
  const int i16 = lane & 15, q4 = i16 >> 2, p4 = i16 & 3, blk = (lane >> 4) & 1;
  const int b = bh >> 4, hd = bh & 15;
  const int qbase = qb == 0 ? -112 : 16 + 128 * (qb - 1);
  const int ntiles = 2 * qb + 1;
  const u16* kf = (const u16*)(p.ws + OFF_S0) + hd * 128; const u16* vf = (const u16*)(p.ws + OFF_S1) + hd * 128;
  u16* qo = (u16*)(p.ws + OFF_S2) + hd * 128;
  const float* cum = (const float*)(p.ws + OFF_CUM) + (size_t)bh * 2112;
  float* sCum = (float*)(smem + 75776);
  const int qp = qbase + 32 * w + r;
  const size_t tq = (size_t)b * LL + (qp >= 0 ? qp : 0);
  bf16x8 qf[8];
  {
    const u32x4 z4 = {0u, 0u, 0u, 0u};
#pragma unroll
    for (int ks = 0; ks < 8; ++ks) {
      u32x4 v = z4;
      if (qp >= 0) v = *(const u32x4*)(qo + tq * 2048 + 16 * ks + 8 * h);
      qf[ks] = __builtin_bit_cast(bf16x8, v);
    }
  }
  const float cq = qp >= 0 ? cum[qp + 48] : 0.f;
  float ubq;
  {
    float qn2 = 0.f;
#pragma unroll
    for (int ks = 0; ks < 8; ++ks) {
      const u32x4 v = __builtin_bit_cast(u32x4, qf[ks]);
#pragma unroll
      for (int i = 0; i < 4; ++i) { const float x0 = bflo(v[i]), x1 = bfhi(v[i]); qn2 += x0 * x0 + x1 * x1; }
    }
    qn2 += __shfl_xor(qn2, 32);
    ubq = sqrtf(qn2);
  }
  int* sFlag = (int*)(smem + 75776 + 512);
  float* sKm = (float*)(smem + 75776 + 512 + 32);
  float kpart = 0.f;
  {
    const int rlo = (b * LL) >> 7, rhi = (b * LL + LL - 1) >> 7;
    const int rbq = rlo + (tid >> 3), e = tid & 7;
    if (rbq <= rhi) { const int half = b - (rbq * 128) / LL; if (half == (e & 1)) kpart = ((const float*)(p.ws + OFF_KMAXP))[(size_t)(rbq * 16 + hd) * 8 + e]; }
#pragma unroll
    for (int d = 1; d < 64; d <<= 1) kpart = fmaxf(kpart, __shfl_xor(kpart, d));
  }
  f32x16 ot[4];
#pragma unroll
  for (int d = 0; d < 4; ++d)
#pragma unroll
    for (int x = 0; x < 16; ++x) ot[d][x] = 0.f;
  float m = -1e30f, lsum = 0.f;
  u32x4 rk[4], rv[4]; float rc = 0.f, rcl = 0.f;
  auto load = [&](int j) {
    const u32x4 z4 = {0u, 0u, 0u, 0u};
#pragma unroll
    for (int i = 0; i < 4; ++i) {
      const int key = (tid >> 4) + 16 * i; const int kp = 64 * j - 48 + key;
      if (kp >= 0) {
        const size_t off = ((size_t)b * LL + kp) * 2048 + (tid & 15) * 8;
        rk[i] = *(const u32x4*)(kf + off); rv[i] = *(const u32x4*)(vf + off);
      } else { rk[i] = z4; rv[i] = z4; }
    }
    if (tid < 64) rc = cum[64 * j + tid];
    rcl = cum[64 * j + 63];
  };
  auto store = [&](int buf) {
    char* sK = smem + buf * 37888; char* sV = sK + 17408;
#pragma unroll
    for (int i = 0; i < 4; ++i) {
      const int key = (tid >> 4) + 16 * i;
      *(u32x4*)(sK + key * 272 + (tid & 15) * 16) = rk[i]; *(u32x4*)(sV + key * 320 + (tid & 15) * 16) = rv[i];
    }
    if (tid < 64) sCum[buf * 64 + tid] = rc;
  };
  __syncthreads();
  if (lane == 0) sKm[w] = kpart;
  load(ntiles - 1); store((ntiles - 1) & 1);
  __syncthreads();
  {
    const float kmx = fmaxf(fmaxf(fmaxf(sKm[0], sKm[1]), fmaxf(sKm[2], sKm[3])), __uint_as_float(((const u32*)(p.ws + OFF_KMAX))[bh]));
    ubq = ubq * sqrtf(kmx) * 1.02f + 0.01f + cq;
  }
  for (int j = ntiles - 1; j >= 0; --j) {
    const int buf = j & 1;
    if (j > 0) load(j - 1);
    const int kp0 = 64 * j - 48;
    if (kp0 <= qbase + 32 * w + 31) {
      const char* sK = smem + buf * 37888; const char* sV = sK + 17408; const float* sC = sCum + buf * 64;
      f32x16 st[2];
#pragma unroll
      for (int jb = 0; jb < 2; ++jb) {
#pragma unroll
        for (int x = 0; x < 16; ++x) st[jb][x] = 0.f;
#pragma unroll
        for (int ks = 0; ks < 8; ++ks) {
          const bf16x8 A = *(const bf16x8*)(sK + (32 * jb + r) * 272 + (16 * ks + 8 * h) * 2);
          st[jb] = MFMA(A, qf[ks], st[jb]);
        }
      }
      float mloc = -1e30f;
#pragma unroll
      for (int jb = 0; jb < 2; ++jb)
#pragma unroll
        for (int g = 0; g < 4; ++g) {
          const float4 ck = *(const float4*)(sC + 32 * jb + 8 * g + 4 * h);
          const float cka[4] = {ck.x, ck.y, ck.z, ck.w};
#pragma unroll
          for (int e = 0; e < 4; ++e) {
            const int kp = kp0 + 32 * jb + 8 * g + 4 * h + e;
            float v = st[jb][4 * g + e] + (cq - cka[e]);
            if (kp > qp || kp < 0) v = -1e30f;
            st[jb][4 * g + e] = v; mloc = fmaxf(mloc, v);
          }
        }
      mloc = fmaxf(mloc, __shfl_xor(mloc, 32));
      const float mnew = fmaxf(m, mloc);
      const float alpha = __expf(m - mnew);
      m = mnew;
      float ps = 0.f;
#pragma unroll
      for (int jb = 0; jb < 2; ++jb)
#pragma unroll
        for (int x = 0; x < 16; ++x) { const float pe = __expf(st[jb][x] - mnew); st[jb][x] = pe; ps += pe; }
      lsum = lsum * alpha + ps;
#pragma unroll
      for (int d = 0; d < 4; ++d)
#pragma unroll
        for (int x = 0; x < 16; ++x) ot[d][x] *= alpha;
      const bf16x8 pb00 = pack8<0>(st[0]), pb01 = pack8<1>(st[0]), pb10 = pack8<0>(st[1]), pb11 = pack8<1>(st[1]);
#pragma unroll
      for (int d = 0; d < 4; ++d) {
        const char* vb = sV + (4 * h + q4) * 320 + (32 * d + 16 * blk + 4 * p4) * 2;
        const bf16x8 A00 = cat8(tr_read(vb), tr_read(vb + 8 * 320));
        const bf16x8 A01 = cat8(tr_read(vb + 16 * 320), tr_read(vb + 24 * 320));
        const bf16x8 A10 = cat8(tr_read(vb + 32 * 320), tr_read(vb + 40 * 320));
        const bf16x8 A11 = cat8(tr_read(vb + 48 * 320), tr_read(vb + 56 * 320));
        ot[d] = MFMA(A00, pb00, ot[d]); ot[d] = MFMA(A01, pb01, ot[d]);
        ot[d] = MFMA(A10, pb10, ot[d]); ot[d] = MFMA(A11, pb11, ot[d]);
      }
    }
    if (j > 0) {
      store(buf ^ 1);
      const bool done = (qp < 0) || (ubq - rcl - m < -110.f);
      const bool wall = __ballot(done) == ~0ull;
      if (lane == 0) sFlag[buf * 4 + w] = wall ? 1 : 0;
    }
    __syncthreads();
    if (j > 0 && (sFlag[buf * 4] & sFlag[buf * 4 + 1] & sFlag[buf * 4 + 2] & sFlag[buf * 4 + 3])) break;
  }
  const float ltot = lsum + __shfl_xor(lsum, 32);
  const float inv = 1.f / ltot;
  if (qp >= 0 && !dry) {
#pragma unroll
    for (int d = 0; d < 4; ++d)
#pragma unroll
      for (int g = 0; g < 4; ++g) {
        u32x2 ov;
        ov[0] = pack2(ot[d][4 * g] * inv, ot[d][4 * g + 1] * inv); ov[1] = pack2(ot[d][4 * g + 2] * inv, ot[d][4 * g + 3] * inv);
        *(u32x2*)(qo + tq * 2048 + 32 * d + 8 * g + 4 * h) = ov;
      }
  }
}

DI void final_unit(const Params& p, int u, int tid) {
  const int w = tid >> 6, l = tid & 63; const size_t rr = (size_t)u * 4 + w;
  float* orow = p.out + rr * 1024; const u16* hr = (const u16*)orow;
  const u32x4 h0 = *(const u32x4*)(hr + 16 * l), h1 = *(const u32x4*)(hr + 16 * l + 8);
  const u32x4 l0 = *(const u32x4*)(hr + 1024 + 16 * l), l1 = *(const u32x4*)(hr + 1024 + 16 * l + 8);
  float v[16];
#pragma unroll
  for (int i = 0; i < 4; ++i) {
    v[2 * i] = bflo(h0[i]) + bflo(l0[i]); v[2 * i + 1] = bfhi(h0[i]) + bfhi(l0[i]);
    v[8 + 2 * i] = bflo(h1[i]) + bflo(l1[i]); v[8 + 2 * i + 1] = bfhi(h1[i]) + bfhi(l1[i]);
  }
  float ss = 0.f;
#pragma unroll
  for (int i = 0; i < 16; ++i) ss += v[i] * v[i];
#pragma unroll
  for (int d = 1; d < 64; d <<= 1) ss += __shfl_xor(ss, d);
  const float rs = rsqrtf(ss * (1.f / 1024.f) + 1e-6f);
#pragma unroll
  for (int i = 0; i < 4; ++i) {
    const float4 g = *(const float4*)(p.final_g + 16 * l + 4 * i);
    float4 o; o.x = v[4 * i] * rs * g.x; o.y = v[4 * i + 1] * rs * g.y; o.z = v[4 * i + 2] * rs * g.z; o.w = v[4 * i + 3] * rs * g.w;
    *(float4*)(orow + 16 * l + 4 * i) = o;
  }
}


#define XB_TMO      128
#define XB_XCNT(j)  (256  + 64 * (j))
#define XB_XSUB(j)  (1280 + 64 * (j))
#define XB_XGEN(j)  (2304 + 64 * (j))
#define XB_TOP      3328
#define XB_TOPGEN   3392
#define XB_SPIN_CAP (1u << 20)
#define LAS __attribute__((address_space(3)))
DI unsigned xb_ld(unsigned* p) { return __hip_atomic_load(p, __ATOMIC_RELAXED, __HIP_MEMORY_SCOPE_AGENT); }
DI unsigned xb_add(unsigned* p, unsigned v) { return __hip_atomic_fetch_add(p, v, __ATOMIC_RELAXED, __HIP_MEMORY_SCOPE_AGENT); }
DI unsigned xb_xcc_id() { return (unsigned)__builtin_amdgcn_s_getreg((3 << 11) | 20) & 0xFu; }
#define XB_SPIN(cond, bar) do { unsigned _sp = 0; while (cond) { __builtin_amdgcn_s_sleep(1); \
    if ((++_sp & 255u) == 0u) { if (xb_ld(&(bar)[XB_TMO])) break; if (_sp > XB_SPIN_CAP) { atomicAdd(&(bar)[XB_TMO], 1u); break; } } } } while (0)
struct XcdBarrier { unsigned* bar; unsigned x; volatile LAS unsigned* st; };
DI XcdBarrier xcd_barrier_post(unsigned* bar, volatile LAS unsigned* st) {
  XcdBarrier b; b.bar = bar; b.x = xb_xcc_id(); b.st = st;
  if (threadIdx.x == 0) st[3] = xb_add(&bar[XB_XCNT(b.x)], 1u);
  return b;
}
DI void xcd_barrier_complete(unsigned* bar, unsigned x, unsigned& nloc, unsigned& nx, unsigned& xi) {
  const unsigned G = gridDim.x * gridDim.y * gridDim.z;
  unsigned sum, cnt, mine, sp = 0u;
  for (;;) {
    sum = 0u; cnt = 0u; mine = 0u; xi = 0u;
#pragma unroll
    for (unsigned j = 0; j < 16; ++j) { const unsigned c = xb_ld(&bar[XB_XCNT(j)]); sum += c; cnt += (c > 0u) ? 1u : 0u; mine = (j == x) ? c : mine; xi += (c > 0u && j < x) ? 1u : 0u; }
    if (sum == G) break;
    __builtin_amdgcn_s_sleep(1);
    if ((++sp & 255u) == 0u) { if (xb_ld(&bar[XB_TMO])) break; if (sp > XB_SPIN_CAP) { atomicAdd(&bar[XB_TMO], 1u); break; } }
  }
  nloc = mine > 0u ? mine : 1u; nx = cnt > 0u ? cnt : 1u;
}
DI void xcd_barrier(const XcdBarrier& b) {
  asm volatile("s_waitcnt vmcnt(0)" ::: "memory");
  __syncthreads();
  if (threadIdx.x == 0) {
    unsigned* bar = b.bar;
    __builtin_amdgcn_s_waitcnt(0);
    unsigned nloc = b.st[0], nx = b.st[1];
    if (nloc == 0u) { unsigned xi; xcd_barrier_complete(bar, b.x, nloc, nx, xi); b.st[0] = nloc; b.st[1] = nx; b.st[2] = xi; }
    const unsigned old = xb_add(&bar[XB_XSUB(b.x)], 1u);
    const unsigned gen = old / nloc;
    if (old + 1u == (gen + 1u) * nloc) {
      __builtin_amdgcn_fence(__ATOMIC_RELEASE, "agent");
      asm volatile("s_waitcnt vmcnt(0)" ::: "memory");
      const unsigned og = xb_add(&bar[XB_TOP], 1u);
      const unsigned tg = og / nx;
      if (og + 1u == (tg + 1u) * nx) xb_add(&bar[XB_TOPGEN], 1u);
      else XB_SPIN(xb_ld(&bar[XB_TOPGEN]) == tg, bar);
      __builtin_amdgcn_fence(__ATOMIC_ACQUIRE, "agent");
      xb_add(&bar[XB_XGEN(b.x)], 1u);
      asm volatile("s_waitcnt vmcnt(0)" ::: "memory");
    } else {
      XB_SPIN(xb_ld(&bar[XB_XGEN(b.x)]) == gen, bar);
      __builtin_amdgcn_fence(__ATOMIC_ACQUIRE, "agent");
      asm volatile("s_waitcnt vmcnt(0)" ::: "memory");
    }
  }
  __syncthreads();
}

constexpr int N_PHASES = 19;
struct Sched { int xi, nx, lr, nloc; };
DI void attn_phase(const Params& p, char* smem, int tid, int dry, const Sched& s) {
  const bool local = (s.nx == 8 && s.nloc == 64);
  const int k = s.lr >> 4;
  const int n = local ? (k == 0 ? 5 : 4) : (2176 - (int)blockIdx.x + (int)gridDim.x - 1) / (int)gridDim.x;
  for (int i = 0; i < n; ++i) {
    int qb, bh;
    if (local) { bh = s.xi + 8 * (s.lr & 15); qb = i == 0 ? 16 - k : i == 1 ? 9 + k : i == 2 ? 8 - k : i == 3 ? 1 + k : 0; }
    else {
      const int u = blockIdx.x + i * gridDim.x;
      if (u >= 2048) { qb = 0; bh = u - 2048; }
      else { const int rnd = u >> 9, kk = (u >> 7) & 3; bh = u & 127; qb = rnd == 0 ? 16 - kk : rnd == 1 ? 9 + kk : rnd == 2 ? 8 - kk : 1 + kk; }
    }
    attn_unit(p, qb, bh, smem, tid, dry);
  }
}

template <int KIND> DI void gemm_phase(const Params& p, int layer, int ncb, char* smem, int tid, int dry, const Sched& s) {
  const int nmain = 129 / s.nx, nlo = 129 - nmain * s.nx;
  const int nmt = nmain * ncb, L = nlo * ncb;
  const int nt = nmt + (L - s.xi + s.nx - 1) / s.nx;
  const int nfull = (nt / s.nloc) * s.nloc;
  auto decode = [&](int tl, int& rb, int& cb) {
    if (tl < nmt) { cb = tl / nmain; rb = s.xi * nmain + (tl - cb * nmain); }
    else { const int l = (tl - nmt) * s.nx + s.xi; const int q = l / ncb; rb = nmain * s.nx + q; cb = l - q * ncb; }
  };
  for (int tl = s.lr; tl < nfull; tl += s.nloc) { int rb, cb; decode(tl, rb, cb); gemm_tile<KIND, 2>(p, layer, rb, cb, 0, 0, smem, tid, dry); }
  for (int su = s.lr; su < 4 * (nt - nfull); su += s.nloc) {
    int rb, cb; decode(nfull + (su >> 2), rb, cb);
    gemm_tile<KIND, 1>(p, layer, rb, cb, (su >> 1) & 1, su & 1, smem, tid, dry);
  }
}
#define PHASE(n, body) if (ph0 <= (n) && (n) < ph1) { Sched sch; if (coop && (n) > 0) { sch.nloc = (int)xst[0]; sch.nx = (int)xst[1]; sch.xi = (int)xst[2]; sch.lr = (int)xst[3]; } \
    else { sch.nx = 8; sch.xi = blockIdx.x & 7; sch.lr = blockIdx.x >> 3; sch.nloc = (gridDim.x + 7 - sch.xi) >> 3; } (void)sch; for (int rep = (probe == (n)) ? 0 : 1; rep < 2; ++rep) { const int dry = (rep == 0); (void)dry; body if (rep == 0) xcd_barrier(xb); } } \
  if (coop && ph0 <= (n) && (n) + 1 < ph1) xcd_barrier(xb);
__global__ void __launch_bounds__(256, 2) fwd_megakernel(Params p, int ph0, int ph1, int coop, int probe) {
  __shared__ __attribute__((aligned(16))) char smem[SMEM_BYTES];
  const int tid = threadIdx.x;
  volatile LAS unsigned* xst = (volatile LAS unsigned*)(smem + SMEM_BYTES - 16);
  if (tid == 0) { xst[0] = 0u; xst[1] = 0u; xst[2] = 0u; xst[3] = 0u; }
  __syncthreads();
  XcdBarrier xb = xcd_barrier_post((unsigned*)(p.ws + OFF_BAR), xst);
  if (coop == 2) cg::this_grid().sync();
  PHASE(0, for (int i = blockIdx.x * 256 + tid; i < 129 * 16 * 8; i += gridDim.x * 256) ((float*)(p.ws + OFF_KMAXP))[i] = 0.f;
        for (int u = blockIdx.x; u < CONV_GLA_UNITS + TT / 4; u += gridDim.x) {
        if (u < CONV_GLA_UNITS) conv_gla(p, u, (float*)smem, tid); else h0_unit(p, u - CONV_GLA_UNITS, tid); })
  PHASE(1, gemm_phase<G_GLAIN>(p, 0, 49, smem, tid, dry, sch);)
  PHASE(2, for (int u = blockIdx.x; u < 1040; u += gridDim.x) prep_unit(p, 0, u, tid, dry, smem);)
  PHASE(3, for (int tl = sch.lr; ; tl += sch.nloc) { const int bhp = sch.xi + sch.nx * (tl >> 4); if (bhp >= 32) break; scan_unit(p, bhp * 16 + (tl & 15), smem, tid, dry); })
  PHASE(4, gemm_phase<G_GLAOUT>(p, 0, 8, smem, tid, dry, sch);)
  PHASE(5, gemm_phase<G_GLAIN>(p, 1, 49, smem, tid, dry, sch);)
  PHASE(6, for (int u = blockIdx.x; u < 1040 + CONV_FOX_UNITS; u += gridDim.x) {
        if (u < 1040) prep_unit(p, 1, u, tid, dry, smem); else conv_fox(p, u - 1040, (float*)smem, tid); })
  PHASE(7, for (int tl = sch.lr; ; tl += sch.nloc) { const int bhp = sch.xi + sch.nx * (tl >> 4); if (bhp >= 32) break; scan_unit(p, bhp * 16 + (tl & 15), smem, tid, dry); })
  PHASE(8, gemm_phase<G_GLAOUT>(p, 1, 8, smem, tid, dry, sch);)
  PHASE(9, gemm_phase<G_KVQ>(p, 0, 49, smem, tid, dry, sch);)
  PHASE(10, for (int u = blockIdx.x; u < 128; u += gridDim.x) cumsum_unit(p, u, tid, smem);)
  PHASE(11, attn_phase(p, smem, tid, dry, sch);)
  PHASE(12, gemm_phase<G_RGATE>(p, 0, 16, smem, tid, dry, sch);)
  PHASE(13, gemm_phase<G_FOXOUT>(p, 0, 8, smem, tid, dry, sch);)
  PHASE(14, gemm_phase<G_Q1>(p, 1, 16, smem, tid, dry, sch);)
  PHASE(15, attn_phase(p, smem, tid, dry, sch);)
  PHASE(16, gemm_phase<G_RGATE>(p, 1, 16, smem, tid, dry, sch);)
  PHASE(17, gemm_phase<G_FOXOUT>(p, 1, 8, smem, tid, dry, sch);)
  PHASE(18, for (int u = blockIdx.x; u < 4096; u += gridDim.x) final_unit(p, u, tid);)
}

extern "C" void kernel_launch(void* const* d_in, const int* in_sizes, int n_in, void* d_out, int out_size, void* d_ws,
                              size_t ws_size, hipStream_t stream) {
  Params p{};
  p.x = (const float*)d_in[0]; p.meta = (const float*)d_in[1]; p.norm_g = (const float*)d_in[2];
  p.gla_w_in = (const float*)d_in[3]; p.gla_w_gate_up = (const float*)d_in[4]; p.gla_b_gate = (const float*)d_in[5];
  p.gla_hn_g = (const float*)d_in[6]; p.gla_w_out = (const float*)d_in[7]; p.kv_norm_g = (const float*)d_in[8];
  p.fox_w_kv = (const float*)d_in[9]; p.fox_b_forget = (const float*)d_in[10]; p.fox_w_in = (const float*)d_in[11];
  p.fox_w_out = (const float*)d_in[12]; p.final_g = (const float*)d_in[13];
  p.out = (float*)d_out; p.ws = (char*)d_ws;
  if (ws_size < WS_END) { fprintf(stderr, "workspace too small: %zu < %zu\n", ws_size, (size_t)WS_END); return; }
  static int grid_blocks = 0;
  if (!grid_blocks) {
    int dev = 0, cus = 0, per_cu = 0;
    hipGetDevice(&dev);
    hipDeviceGetAttribute(&cus, hipDeviceAttributeMultiprocessorCount, dev);
    hipOccupancyMaxActiveBlocksPerMultiprocessor(&per_cu, fwd_megakernel, 256, 0);
    if (per_cu > 2) per_cu = 2;
    grid_blocks = cus * per_cu;
  }
  hipMemsetAsync((char*)d_ws + OFF_BAR, 0, BAR_BYTES, stream);
  int ph0 = 0, ph1 = N_PHASES, coop = 1, probe = PROBE_PHASE;
  void* args[] = {&p, &ph0, &ph1, &coop, &probe};
  hipError_t e = hipLaunchCooperativeKernel((void*)fwd_megakernel, dim3(grid_blocks), dim3(256), args, 0, stream);
  if (e != hipSuccess) fprintf(stderr, "cooperative launch failed: %s (grid %d)\n", hipGetErrorString(e), grid_blocks);
}
```

```cpp
#include <hip/hip_runtime.h>
#include <hip/hip_cooperative_groups.h>
#include <cstdio>
namespace cg = cooperative_groups;

typedef unsigned short u16;
typedef unsigned int u32;
typedef short s16x4 __attribute__((ext_vector_type(4)));
typedef short bf16x8 __attribute__((ext_vector_type(8)));
typedef float f32x16 __attribute__((ext_vector_type(16)));
typedef float f32x2 __attribute__((ext_vector_type(2)));
typedef __bf16 bf16x2_t __attribute__((ext_vector_type(2)));
typedef u32 u32x4 __attribute__((ext_vector_type(4)));
typedef u32 u32x2 __attribute__((ext_vector_type(2)));

#define DI __device__ __forceinline__
#define MFMA(a, b, c) __builtin_amdgcn_mfma_f32_32x32x16_bf16((a), (b), (c), 0, 0, 0)

constexpr int NB = 8, LL = 2064, TT = NB * LL;
constexpr size_t SLOT = (size_t)TT * 2048 * 2;
constexpr size_t OFF_S0 = 0, OFF_S1 = SLOT, OFF_S2 = 2 * SLOT, OFF_W = 3 * SLOT;
constexpr int WPAD = 64;
constexpr size_t WIN_SZ = (size_t)6272 * (1024 + WPAD) * 2;
constexpr size_t W4M = (size_t)2048 * (1024 + WPAD) * 2;
constexpr size_t OFF_WIN = OFF_W;
constexpr size_t OFF_WOUT = OFF_W + 2 * WIN_SZ;
constexpr size_t OFF_WKV = OFF_W;
constexpr size_t WKV_SZ = (size_t)4224 * (1024 + WPAD) * 2;
constexpr size_t OFF_WQ0 = OFF_WKV + WKV_SZ;
constexpr size_t OFF_WR0 = OFF_WQ0 + W4M;
constexpr size_t OFF_WQ1 = OFF_WR0 + W4M;
constexpr size_t OFF_WR1 = OFF_WQ1 + W4M;
static_assert(OFF_WR1 + W4M <= OFF_WOUT, "fox weights must fit in gla w_in region");
constexpr size_t OFF_FWOUT = OFF_WOUT + 2 * W4M;
constexpr size_t OFF_SMALL = OFF_FWOUT + 2 * W4M;
constexpr size_t OFF_HMETA = OFF_SMALL;
constexpr size_t OFF_SSQ = OFF_HMETA + 128 * 4096;
constexpr size_t OFF_GLOW = OFF_SSQ + (size_t)TT * 32 * 4;
constexpr size_t OFF_EB = OFF_GLOW + (size_t)TT * 16 * 4;
constexpr size_t OFF_SSQO = OFF_EB + (size_t)8 * 65 * 1024 * 4;
constexpr size_t OFF_FLOG = OFF_SSQO + (size_t)TT * 64 * 4;
constexpr size_t OFF_CUM = OFF_FLOG + (size_t)TT * 16 * 4;
constexpr size_t OFF_BAR = OFF_CUM + (size_t)128 * 2112 * 4;
constexpr size_t OFF_KMAX = OFF_BAR + 3456 * 4;
constexpr size_t BAR_BYTES = 3456 * 4 + 512;
constexpr size_t OFF_KMAXP = OFF_BAR + BAR_BYTES;
constexpr size_t WS_END = OFF_KMAXP + (size_t)129 * 16 * 8 * 4;
static_assert(WS_END <= 268435456, "workspace");

constexpr int SMEM_BYTES = 76800;
constexpr int PROBE_PHASE = -1;

struct Params {
  const float *x, *meta, *norm_g, *gla_w_in, *gla_w_gate_up, *gla_b_gate, *gla_hn_g, *gla_w_out;
  const float *kv_norm_g, *fox_w_kv, *fox_b_forget, *fox_w_in, *fox_w_out, *final_g;
  float* out;
  char* ws;
};

DI u32 pack2(float a, float b) { f32x2 v = {a, b}; bf16x2_t r = __builtin_convertvector(v, bf16x2_t); return __builtin_bit_cast(u32, r); }
DI u16 f2bf(float x) { __bf16 b = (__bf16)x; return __builtin_bit_cast(u16, b); }
DI float bf2f(u32 b) { return __uint_as_float(b << 16); }
DI float bflo(u32 v) { return __uint_as_float(v << 16); }
DI float bfhi(u32 v) { return __uint_as_float(v & 0xffff0000u); }
DI int crow(int x, int h) { return (x & 3) + 8 * (x >> 2) + 4 * h; }
template <int S> DI bf16x8 pack8(const f32x16& x) {
  u32x4 p;
  p[0] = pack2(x[8 * S + 0], x[8 * S + 1]); p[1] = pack2(x[8 * S + 2], x[8 * S + 3]);
  p[2] = pack2(x[8 * S + 4], x[8 * S + 5]); p[3] = pack2(x[8 * S + 6], x[8 * S + 7]);
  return __builtin_bit_cast(bf16x8, p);
}
DI s16x4 tr_read(const char* lds_ptr) {
  return __builtin_amdgcn_ds_read_tr16_b64_v4i16((s16x4 __attribute__((address_space(3)))*)(lds_ptr));
}
DI bf16x8 cat8(s16x4 lo, s16x4 hi) { return __builtin_shufflevector(lo, hi, 0, 1, 2, 3, 4, 5, 6, 7); }
DI float dpp_x1(float v) { return __int_as_float(__builtin_amdgcn_update_dpp(0, __float_as_int(v), 0xB1, 0xF, 0xF, true)); }
DI float dpp_x2(float v) { return __int_as_float(__builtin_amdgcn_update_dpp(0, __float_as_int(v), 0x4E, 0xF, 0xF, true)); }
DI float dpp_m8(float v) { return __int_as_float(__builtin_amdgcn_update_dpp(0, __float_as_int(v), 0x141, 0xF, 0xF, true)); }
DI float silu(float x) { return x / (1.f + __expf(-x)); }
DI float logsig(float x) { return fminf(x, 0.f) - log1pf(expf(-fabsf(x))); }
DI float logsig_fast(float x) { return fminf(x, 0.f) - __logf(1.f + __expf(-fabsf(x))); }

DI u16* hrow(const Params& p, int t) {
  const int b = t / LL, pp = t - b * LL;
  const bool meta = pp < 16;
  char* base = meta ? p.ws + OFF_HMETA : (char*)p.out;
  const int idx = meta ? b * 16 + pp : b * 2048 + pp - 16;
  return (u16*)(base + (size_t)idx * 4096);
}

struct ConvJob { const float* src; const float* g; u16* dst; int ldsrc, gmask, K, cmode, coff, nvalid, ntn; };
DI int conv_srccol(const ConvJob& j, int n) {
  if (j.cmode == 1) { if (n < 4096) return n; if (n < 6144) return n + 16; if (n < 6160) return n - 2048; return -1; }
  return n < j.nvalid ? j.coff + n : -1;
}
DI void conv_unit(const ConvJob& j, int unit, float* sm, int tid) {
  const int nt = unit % j.ntn, kt = unit / j.ntn;
  const int n0 = nt * 64, k0 = kt * 64;
  __syncthreads();
  {
    const int nn = tid & 63; const int sc = conv_srccol(j, n0 + nn);
    float vv[16], gg[16];
#pragma unroll
    for (int i = 0; i < 16; ++i) {
      const int k = k0 + i * 4 + (tid >> 6);
      vv[i] = sc >= 0 ? j.src[(size_t)k * j.ldsrc + sc] : 0.f;
      gg[i] = j.g ? j.g[k & j.gmask] : 1.f;
    }
#pragma unroll
    for (int i = 0; i < 16; ++i) sm[(i * 4 + (tid >> 6)) * 65 + nn] = vv[i] * gg[i];
  }
  __syncthreads();
  {
    const int kk = tid & 63;
#pragma unroll
    for (int i = 0; i < 16; ++i) { const int n = i * 4 + (tid >> 6); j.dst[(size_t)(n0 + n) * (j.K + WPAD) + k0 + kk] = f2bf(sm[kk * 65 + n]); }
  }
}
constexpr int CONV_GLA_UNITS = 2 * 1568 + 2 * 512;
constexpr int CONV_FOX_UNITS = 1056 + 4 * 512 + 2 * 512;
DI void conv_gla(const Params& p, int u, float* sm, int tid) {
  ConvJob j;
  if (u < 3136) {
    const int l = u / 1568; u -= l * 1568;
    j.src = p.gla_w_in + (size_t)l * 1024 * 6160; j.ldsrc = 6160; j.g = p.norm_g + l * 1024; j.gmask = 1023;
    j.dst = (u16*)(p.ws + OFF_WIN + l * WIN_SZ); j.K = 1024; j.cmode = 1; j.coff = 0; j.nvalid = 0; j.ntn = 98;
  } else {
    u -= 3136; const int l = u / 512; u -= l * 512;
    j.src = p.gla_w_out + (size_t)l * 2048 * 1024; j.ldsrc = 1024; j.g = p.gla_hn_g + l * 512; j.gmask = 511;
    j.dst = (u16*)(p.ws + OFF_WOUT + l * W4M); j.K = 2048; j.cmode = 0; j.coff = 0; j.nvalid = 1024; j.ntn = 16;
  }
  conv_unit(j, u, sm, tid);
}
DI void conv_fox(const Params& p, int u, float* sm, int tid) {
  ConvJob j; j.cmode = 0;
  if (u < 1056) {
    j.src = p.fox_w_kv; j.ldsrc = 4112; j.g = p.kv_norm_g; j.gmask = 1023; j.dst = (u16*)(p.ws + OFF_WKV); j.K = 1024;
    j.coff = 0; j.nvalid = 4112; j.ntn = 66;
  } else if (u < 1056 + 2048) {
    u -= 1056; const int m = u / 512; u -= m * 512;
    const int l = m >> 1;
    j.src = p.fox_w_in + (size_t)l * 1024 * 4096; j.ldsrc = 4096; j.g = p.norm_g + (2 + l) * 1024; j.gmask = 1023;
    j.dst = (u16*)(p.ws + OFF_WQ0 + (size_t)m * W4M); j.K = 1024; j.coff = (m & 1) * 2048; j.nvalid = 2048; j.ntn = 32;
  } else {
    u -= 1056 + 2048; const int l = u / 512; u -= l * 512;
    j.src = p.fox_w_out + (size_t)l * 2048 * 1024; j.ldsrc = 1024; j.g = nullptr; j.gmask = 0;
    j.dst = (u16*)(p.ws + OFF_FWOUT + l * W4M); j.K = 2048; j.coff = 0; j.nvalid = 1024; j.ntn = 16;
  }
  conv_unit(j, u, sm, tid);
}

DI void h0_unit(const Params& p, int unit, int tid) {
  const int w = tid >> 6, l = tid & 63; const int t = unit * 4 + w; const int b = t / LL, pp = t - b * LL;
  const float* src = pp < 16 ? p.meta + pp * 1024 : p.x + ((size_t)b * 2048 + pp - 16) * 1024;
  u16* hr = hrow(p, t);
  float* ssq = (float*)(p.ws + OFF_SSQ) + (size_t)t * 32;
  float4 vin[4];
#pragma unroll
  for (int i = 0; i < 4; ++i) vin[i] = *(const float4*)(src + 4 * l + 256 * i);
#pragma unroll
  for (int i = 0; i < 4; ++i) {
    const int c = 4 * l + 256 * i; const float4 v = vin[i];
    u32x2 hi, lo;
    hi[0] = pack2(v.x, v.y); hi[1] = pack2(v.z, v.w);
    lo[0] = pack2(v.x - bflo(hi[0]), v.y - bfhi(hi[0])); lo[1] = pack2(v.z - bflo(hi[1]), v.w - bfhi(hi[1]));
    *(u32x2*)(hr + c) = hi; *(u32x2*)(hr + 1024 + c) = lo;
    float s = v.x * v.x + v.y * v.y + v.z * v.z + v.w * v.w;
    s += dpp_x1(s); s += dpp_x2(s); s += dpp_m8(s);
    if ((l & 7) == 0) ssq[8 * i + (l >> 3)] = s;
  }
}

enum { G_GLAIN = 0, G_GLAOUT, G_KVQ, G_Q1, G_RGATE, G_FOXOUT };

template <bool FOLD, int SUB, class Pre>
DI void gemm_main(const u16* a0, const u16* a1, const u16* a2, const u16* a3, const u16* b0, size_t bstr, int nk, int rot,
                  char* smem, const float* sStat, f32x16 (&acc)[SUB][SUB], f32x16 (&tot)[SUB][SUB], int tid, Pre&& pre) {
  const int w = tid >> 6, lane = tid & 63, r = lane & 31, h = lane >> 5, wr = w >> 1, wc = w & 1;
  constexpr int NCH = 2 * SUB;
  typedef __attribute__((address_space(3))) void* lds_ptr_t;
  auto issue = [&](int kt) {
    const int ko = ((kt + rot) & (nk - 1)) * 64;
    char* st = smem + (kt & 1) * 32768 + tid * 16;
    __builtin_amdgcn_global_load_lds((const u32*)(a0 + ko), (lds_ptr_t)(st), 16, 0, 0);
    __builtin_amdgcn_global_load_lds((const u32*)(a1 + ko), (lds_ptr_t)(st + 4096), 16, 0, 0);
    if (SUB == 2) {
      __builtin_amdgcn_global_load_lds((const u32*)(a2 + ko), (lds_ptr_t)(st + 8192), 16, 0, 0);
      __builtin_amdgcn_global_load_lds((const u32*)(a3 + ko), (lds_ptr_t)(st + 12288), 16, 0, 0);
    }
#pragma unroll
    for (int i = 0; i < NCH; ++i)
      __builtin_amdgcn_global_load_lds((const u32*)(b0 + i * bstr + ko), (lds_ptr_t)(st + 16384 + i * 4096), 16, 0, 0);
  };
  const int fr = (r >> 1) & 7;
  int aofs[4], bofs[4];
#pragma unroll
  for (int ks = 0; ks < 4; ++ks) {
    aofs[ks] = (32 * SUB * wr + r) * 128 + (((2 * ks + h) ^ fr) * 16);
    bofs[ks] = 16384 + (32 * SUB * wc + r) * 128 + (((2 * ks + h) ^ fr) * 16);
  }
  issue(0);
  pre();
  asm volatile("s_waitcnt vmcnt(0)" ::: "memory");
  __syncthreads();
  for (int kt = 0; kt < nk; ++kt) {
    if (kt + 1 < nk) issue(kt + 1);
    const char* cur = smem + (kt & 1) * 32768;
#pragma unroll
    for (int ks = 0; ks < 4; ++ks) {
      bf16x8 af[SUB], bf[SUB];
#pragma unroll
      for (int mi = 0; mi < SUB; ++mi) af[mi] = *(const bf16x8*)(cur + aofs[ks] + mi * 32 * 128);
#pragma unroll
      for (int ni = 0; ni < SUB; ++ni) bf[ni] = *(const bf16x8*)(cur + bofs[ks] + ni * 32 * 128);
#pragma unroll
      for (int mi = 0; mi < SUB; ++mi)
#pragma unroll
        for (int ni = 0; ni < SUB; ++ni) acc[mi][ni] = MFMA(af[mi], bf[ni], acc[mi][ni]);
    }
    if (FOLD && (kt & 7) == 7) {
      const int head = ((kt + rot) & (nk - 1)) >> 3;
#pragma unroll
      for (int mi = 0; mi < SUB; ++mi)
#pragma unroll
        for (int x = 0; x < 16; ++x) {
          const float sc = sStat[(32 * SUB * wr + 32 * mi + crow(x, h)) * 4 + head];
#pragma unroll
          for (int ni = 0; ni < SUB; ++ni) { tot[mi][ni][x] += sc * acc[mi][ni][x]; acc[mi][ni][x] = 0.f; }
        }
    }
    asm volatile("s_waitcnt vmcnt(0)" ::: "memory");
    __syncthreads();
  }
}

template <int KIND, int SUB>
DI void gemm_tile(const Params& p, int layer, int rb, int cb, int sr, int sc, char* smem, int tid, int dry) {
  const int w = tid >> 6, lane = tid & 63, r = lane & 31, h = lane >> 5, wr = w >> 1, wc = w & 1;
  const int r0 = tid >> 3, kc = tid & 7;
  float* sStat = (float*)(smem + 73728);
  constexpr bool HSRC = (KIND == G_GLAIN || KIND == G_KVQ || KIND == G_Q1 || KIND == G_RGATE);
  constexpr int K = HSRC ? 1024 : 2048;
  constexpr int R = 64 * SUB;
  const int row0 = rb * 128 + (SUB == 1 ? 64 * sr : 0);
  const int col0 = SUB == 1 ? 64 * sc : 0;
  __syncthreads();
  const u16 *a0, *a1, *a2, *a3;
  const int kcs = (kc ^ ((r0 >> 1) & 7)) * 8;
  if (HSRC) {
    a0 = hrow(p, row0 + r0) + kcs; a1 = hrow(p, row0 + r0 + 32) + kcs;
    a2 = SUB == 2 ? hrow(p, row0 + r0 + 64) + kcs : a0; a3 = SUB == 2 ? hrow(p, row0 + r0 + 96) + kcs : a0;
  } else {
    const u16* base = (const u16*)(p.ws + (KIND == G_GLAOUT ? OFF_S1 : OFF_S2)) + (size_t)(row0 + r0) * 2048 + kcs;
    a0 = base; a1 = base + (size_t)32 * 2048; a2 = base + (size_t)64 * 2048; a3 = base + (size_t)96 * 2048;
  }
  const u16* bt;
  if (KIND == G_GLAIN) bt = (const u16*)(p.ws + OFF_WIN + layer * WIN_SZ) + (size_t)cb * 128 * (1024 + WPAD);
  else if (KIND == G_GLAOUT) bt = (const u16*)(p.ws + OFF_WOUT + layer * W4M) + (size_t)cb * 128 * (2048 + WPAD);
  else if (KIND == G_KVQ) bt = cb < 33 ? (const u16*)(p.ws + OFF_WKV) + (size_t)cb * 128 * (1024 + WPAD) : (const u16*)(p.ws + OFF_WQ0) + (size_t)(cb - 33) * 128 * (1024 + WPAD);
  else if (KIND == G_Q1) bt = (const u16*)(p.ws + OFF_WQ1) + (size_t)cb * 128 * (1024 + WPAD);
  else if (KIND == G_RGATE) bt = (const u16*)(p.ws + (layer ? OFF_WR1 : OFF_WR0)) + (size_t)cb * 128 * (1024 + WPAD);
  else bt = (const u16*)(p.ws + OFF_FWOUT + layer * W4M) + (size_t)cb * 128 * (2048 + WPAD);
  const u16* b0 = bt + (size_t)(col0 + r0) * (K + WPAD) + kcs;

  f32x16 acc[SUB][SUB], tot[SUB][SUB];
#pragma unroll
  for (int mi = 0; mi < SUB; ++mi)
#pragma unroll
    for (int ni = 0; ni < SUB; ++ni)
#pragma unroll
      for (int x = 0; x < 16; ++x) { acc[mi][ni][x] = 0.f; tot[mi][ni][x] = 0.f; }
  auto stats = [&]() {
  if (HSRC) {
    if (tid < R) {
      const float4* s4 = (const float4*)((const float*)(p.ws + OFF_SSQ) + (size_t)(row0 + tid) * 32);
      float s = 0.f;
#pragma unroll
      for (int i = 0; i < 8; ++i) { const float4 v = s4[i]; s += v.x + v.y + v.z + v.w; }
      sStat[tid] = rsqrtf(s * (1.f / 1024.f) + 1e-6f);
    }
  } else if (KIND == G_GLAOUT) {
#pragma unroll
    for (int e = 0; e < 2; ++e) {
      const int idx = tid * 2 + e;
      if (idx < R * 4) {
        const float4* s4 = (const float4*)((const float*)(p.ws + OFF_SSQO) + ((size_t)row0 * 4 + idx) * 16);
        float s = 0.f;
#pragma unroll
        for (int i = 0; i < 4; ++i) { const float4 v = s4[i]; s += v.x + v.y + v.z + v.w; }
        sStat[idx] = rsqrtf(s * (1.f / 512.f) + 1e-6f);
      }
    }
  }
  };
  const int rot = (KIND == G_GLAOUT) ? 8 * ((rb + sr) & 3) : ((rb * 5 + sr * 7) & (K / 64 - 1));
  gemm_main<KIND == G_GLAOUT, SUB>(a0, a1, a2, a3, b0, (size_t)32 * (K + WPAD), K / 64, rot, smem, sStat, acc, tot, tid, stats);

  constexpr int CP = R + 4;
  constexpr int NCC = R / 8;
  constexpr int RPP = 256 / NCC;
  constexpr int NPASS = R / RPP;
  if (KIND == G_GLAOUT || KIND == G_FOXOUT) {
    float* ssq = (float*)(p.ws + OFF_SSQ);
    float* sC = (float*)smem;
#pragma unroll
    for (int mi = 0; mi < SUB; ++mi)
#pragma unroll
      for (int x = 0; x < 16; ++x)
#pragma unroll
        for (int ni = 0; ni < SUB; ++ni)
          sC[(32 * SUB * wr + 32 * mi + crow(x, h)) * CP + 32 * SUB * wc + 32 * ni + r] = (KIND == G_GLAOUT) ? tot[mi][ni][x] : acc[mi][ni][x];
    __syncthreads();
    const int cc = tid % NCC, rq = tid / NCC;
    u32x4 vhi[NPASS], vlo[NPASS];
#pragma unroll
    for (int j = 0; j < NPASS; ++j) {
      const u16* hr = hrow(p, row0 + rq + RPP * j) + cb * 128 + col0 + cc * 8;
      vhi[j] = *(const u32x4*)hr; vlo[j] = *(const u32x4*)(hr + 1024);
    }
#pragma unroll
    for (int j = 0; j < NPASS; ++j) {
      const int row = rq + RPP * j; const int t = row0 + row;
      u16* hr = hrow(p, t) + cb * 128 + col0 + cc * 8;
      const float4 c0 = *(const float4*)(sC + row * CP + cc * 8), c1 = *(const float4*)(sC + row * CP + cc * 8 + 4);
      const float cv[8] = {c0.x, c0.y, c0.z, c0.w, c1.x, c1.y, c1.z, c1.w};
      u32x4 nh, nl; float sq = 0.f;
#pragma unroll
      for (int i = 0; i < 4; ++i) {
        const float h0 = bflo(vhi[j][i]) + bflo(vlo[j][i]) + cv[2 * i], h1 = bfhi(vhi[j][i]) + bfhi(vlo[j][i]) + cv[2 * i + 1];
        nh[i] = pack2(h0, h1); nl[i] = pack2(h0 - bflo(nh[i]), h1 - bfhi(nh[i]));
        sq += h0 * h0 + h1 * h1;
      }
      sq += dpp_x1(sq); sq += dpp_x2(sq);
      if (!dry) {
        *(u32x4*)hr = nh; *(u32x4*)(hr + 1024) = nl;
        if ((cc & 3) == 0) ssq[(size_t)t * 32 + ((cb * 128 + col0 + cc * 8) >> 5)] = sq;
      }
    }
  } else {
    u16* s0 = (u16*)(p.ws + OFF_S0); u16* s1 = (u16*)(p.ws + OFF_S1); u16* s2 = (u16*)(p.ws + OFF_S2);
    u16* dst = s2 + cb * 128; float scale = 1.f; int mode = 0;
    if (KIND == G_GLAIN) {
      if (cb < 16) { dst = s0 + cb * 128; scale = cb < 8 ? 0.0625f : 1.f; }
      else if (cb < 32) dst = s1 + (cb - 16) * 128;
      else if (cb < 48) dst = s2 + (cb - 32) * 128;
      else mode = 1;
    } else if (KIND == G_KVQ) {
      if (cb < 16) dst = s0 + cb * 128;
      else if (cb < 32) dst = s1 + (cb - 16) * 128;
      else if (cb == 32) mode = 2;
      else { dst = s2 + (cb - 33) * 128; scale = 0.08838834764831845f; }
    } else if (KIND == G_Q1) { scale = 0.08838834764831845f; }
    else mode = 3;
    float* sC = (float*)smem;
#pragma unroll
    for (int mi = 0; mi < SUB; ++mi)
#pragma unroll
      for (int x = 0; x < 16; ++x) {
        const int rl = 32 * SUB * wr + 32 * mi + crow(x, h);
        const float rs = sStat[rl] * scale;
#pragma unroll
        for (int ni = 0; ni < SUB; ++ni) sC[rl * CP + 32 * SUB * wc + 32 * ni + r] = acc[mi][ni][x] * rs;
      }
    __syncthreads();
    if (mode == 0 || mode == 3) {
      const int cc = tid % NCC, rq = tid / NCC;
      u16* d0 = dst + ((size_t)row0 + rq) * 2048 + col0 + cc * 8;
      u32x4 vo[NPASS];
      float kmx0 = 0.f, kmx1 = 0.f;
      if (KIND == G_RGATE) {
#pragma unroll
        for (int j = 0; j < NPASS; ++j) vo[j] = *(const u32x4*)(d0 + (size_t)RPP * j * 2048);
      }
#pragma unroll
      for (int j = 0; j < NPASS; ++j) {
        const int row = rq + RPP * j;
        const float4 c0 = *(const float4*)(sC + row * CP + cc * 8), c1 = *(const float4*)(sC + row * CP + cc * 8 + 4);
        const float cv[8] = {c0.x, c0.y, c0.z, c0.w, c1.x, c1.y, c1.z, c1.w};
        u32x4 nv;
#pragma unroll
        for (int i = 0; i < 4; ++i) {
          if (KIND == G_RGATE) nv[i] = pack2(bflo(vo[j][i]) * silu(cv[2 * i]), bfhi(vo[j][i]) * silu(cv[2 * i + 1]));
          else nv[i] = pack2(cv[2 * i], cv[2 * i + 1]);
        }
        if (!(KIND == G_RGATE && dry)) *(u32x4*)(d0 + (size_t)RPP * j * 2048) = nv;
        if (KIND == G_KVQ && cb < 16) {
          float s = 0.f;
#pragma unroll
          for (int i = 0; i < 4; ++i) { const float x0 = bflo(nv[i]), x1 = bfhi(nv[i]); s += x0 * x0 + x1 * x1; }
          s += __shfl_xor(s, 1); s += __shfl_xor(s, 2); s += __shfl_xor(s, 4);
          if (NCC == 16) s += __shfl_xor(s, 8);
          if (SUB == 1) {
            if (cc == 0) atomicMax((u32*)(p.ws + OFF_KMAX) + ((row0 + row) / LL) * 16 + cb, __float_as_uint(2.f * s));
          } else if ((row0 + row) / LL == row0 / LL) kmx0 = fmaxf(kmx0, s); else kmx1 = fmaxf(kmx1, s);
        }
      }
      if (KIND == G_KVQ && SUB == 2 && cb < 16) {
        kmx0 = fmaxf(kmx0, __shfl_xor(kmx0, 16)); kmx0 = fmaxf(kmx0, __shfl_xor(kmx0, 32));
        kmx1 = fmaxf(kmx1, __shfl_xor(kmx1, 16)); kmx1 = fmaxf(kmx1, __shfl_xor(kmx1, 32));
        if (lane == 0) { float* kp = (float*)(p.ws + OFF_KMAXP) + ((size_t)(rb * 16 + cb) * 8 + w * 2); kp[0] = kmx0; kp[1] = kmx1; }
      }
    } else if (col0 == 0 && tid < R) {
      float* fdst = (float*)(p.ws + (mode == 1 ? OFF_GLOW : OFF_FLOG)) + ((size_t)row0 + tid) * 16;
#pragma unroll
      for (int q = 0; q < 4; ++q) {
        float4 v = *(const float4*)(sC + tid * CP + 4 * q);
        if (mode == 2) {
          const float4 bq = *(const float4*)(p.fox_b_forget + 4 * q);
          v.x = logsig(v.x + bq.x); v.y = logsig(v.y + bq.y); v.z = logsig(v.z + bq.z); v.w = logsig(v.w + bq.w);
        }
        *(float4*)(fdst + 4 * q) = v;
      }
    }
  }
}

DI void prep_unit(const Params& p, int layer, int u, int tid, int dry, char* smem) {
  const int half = u & 1, bc = (u & 1023) >> 1;
  const int c = u < 1024 ? 1 + (bc & 63) : 0, b = u < 1024 ? bc >> 6 : bc;
  const int col = half * 512 + tid * 2;
  const float* Wg = p.gla_w_gate_up + (size_t)layer * 16 * 1024; const float* bg = p.gla_b_gate + layer * 1024;
  u16* qk = (u16*)(p.ws + OFF_S0); const float* glow = (const float*)(p.ws + OFF_GLOW);
  float* sG = (float*)smem;
  const int pos0 = 32 * c - 16;
  __syncthreads();
  if (tid < 128) {
    const int i = tid >> 2; const int pp = pos0 + i; float4 v = {0.f, 0.f, 0.f, 0.f};
    if (pp >= 0) v = *(const float4*)(glow + ((size_t)b * LL + pp) * 16 + (tid & 3) * 4);
    *(float4*)(sG + i * 16 + (tid & 3) * 4) = v;
  }
  float w0[16], w1[16];
#pragma unroll
  for (int r = 0; r < 16; ++r) { const float2 v = *(const float2*)(Wg + r * 1024 + col); w0[r] = v.x; w1[r] = v.y; }
  const float bb0 = bg[col], bb1 = bg[col + 1];
  u32 qv[32], kv[32];
#pragma unroll
  for (int i = 0; i < 32; ++i) {
    const int pp = pos0 + i; qv[i] = 0u; kv[i] = 0u;
    if (pp >= 0) { const u16* q = qk + ((size_t)b * LL + pp) * 2048 + col; qv[i] = *(const u32*)q; kv[i] = *(const u32*)(q + 1024); }
  }
  __syncthreads();
  float c0 = 0.f, c1 = 0.f;
#pragma unroll
  for (int i = 0; i < 32; ++i) {
    const int pp = pos0 + i;
    if (pp >= 0) {
      float x0 = bb0, x1 = bb1;
#pragma unroll
      for (int r4 = 0; r4 < 4; ++r4) {
        const float4 g = *(const float4*)(sG + i * 16 + r4 * 4);
        x0 += g.x * w0[4 * r4] + g.y * w0[4 * r4 + 1] + g.z * w0[4 * r4 + 2] + g.w * w0[4 * r4 + 3];
        x1 += g.x * w1[4 * r4] + g.y * w1[4 * r4 + 1] + g.z * w1[4 * r4 + 2] + g.w * w1[4 * r4 + 3];
      }
      c0 += logsig_fast(x0) * 0.0625f; c1 += logsig_fast(x1) * 0.0625f;
      const float e0 = __expf(c0), e1 = __expf(c1), f0 = __expf(-c0), f1 = __expf(-c1);
      u16* q = qk + ((size_t)b * LL + pp) * 2048 + col;
      const u32 nq = pack2(bflo(qv[i]) * e0, bfhi(qv[i]) * e1), nk = pack2(bflo(kv[i]) * f0, bfhi(kv[i]) * f1);
      if (!dry) { *(u32*)q = nq; *(u32*)(q + 1024) = nk; }
    }
  }
  float2 ev; ev.x = __expf(c0); ev.y = __expf(c1);
  *(float2*)((float*)(p.ws + OFF_EB) + ((size_t)b * 65 + c) * 1024 + col) = ev;
}

struct ScanRegs { u32x4 pq[4], pk[4], pv, pe; u32x2 pr; };
DI void scan_unit(const Params& p, int u, char* smem, int tid, int dry) {
  const int w = tid >> 6, lane = tid & 63, r = lane & 31, h = lane >> 5;
  const int i16 = lane & 15, q4 = i16 >> 2, p4 = i16 & 3, blk = (lane >> 4) & 1;
  const int slice = u & 15, head = (u >> 4) & 3, b = u >> 6;
  char* sQ = smem; char* sK = smem + 16896; char* sV = smem + 16896 + 18432;
  float* sEb = (float*)(smem + 16896 + 18432 + 2048); float* sRed = (float*)(smem + 16896 + 18432 + 2048 + 1024);
  const u16* qk = (const u16*)(p.ws + OFF_S0); u16* vo = (u16*)(p.ws + OFF_S1); const u16* rr = (const u16*)(p.ws + OFF_S2);
  const float* eb = (const float*)(p.ws + OFF_EB) + (size_t)b * 65 * 1024 + head * 256;
  float* ssqo = (float*)(p.ws + OFF_SSQO);
  const int dw = 64 * w;
  f32x16 S0, S1;
#pragma unroll
  for (int x = 0; x < 16; ++x) { S0[x] = 0.f; S1[x] = 0.f; }
  const u32x4 z4 = {0u, 0u, 0u, 0u};
  auto load = [&](int c, ScanRegs& R) {
    const int pos0 = 32 * c - 16;
#pragma unroll
    for (int i = 0; i < 4; ++i) {
      const int row = (tid >> 5) + 8 * i; const int pp = pos0 + row;
      if (pp >= 0) {
        const u16* src = qk + ((size_t)b * LL + pp) * 2048 + head * 256 + (tid & 31) * 8;
        R.pq[i] = *(const u32x4*)src; R.pk[i] = *(const u32x4*)(src + 1024);
      } else { R.pq[i] = z4; R.pk[i] = z4; }
    }
    R.pv = z4;
    if (tid < 128) { const int pp = pos0 + (tid >> 2); if (pp >= 0) R.pv = *(const u32x4*)(vo + ((size_t)b * LL + pp) * 2048 + head * 512 + slice * 32 + (tid & 3) * 8); }
    R.pe = z4;
    if (tid < 64) R.pe = *(const u32x4*)(eb + (size_t)c * 1024 + tid * 4);
    { const int pp = pos0 + (tid >> 3); R.pr[0] = 0u; R.pr[1] = 0u;
      if (pp >= 0) R.pr = *(const u32x2*)(rr + ((size_t)b * LL + pp) * 2048 + head * 512 + slice * 32 + (tid & 7) * 4); }
  };
  auto step = [&](int c, ScanRegs& R) {
#pragma unroll
    for (int i = 0; i < 4; ++i) {
      const int row = (tid >> 5) + 8 * i;
      *(u32x4*)(sQ + row * 528 + (tid & 31) * 16) = R.pq[i]; *(u32x4*)(sK + row * 576 + (tid & 31) * 16) = R.pk[i];
    }
    if (tid < 128) *(u32x4*)(sV + (tid >> 2) * 64 + (tid & 3) * 16) = R.pv;
    if (tid < 64) *(u32x4*)(sEb + tid * 4) = R.pe;
    const u32x2 rcur = R.pr;
    __syncthreads();
    if (c + 1 < 65) load(c + 1, R);
    f32x16 pt;
#pragma unroll
    for (int x = 0; x < 16; ++x) pt[x] = 0.f;
#pragma unroll
    for (int s = 0; s < 4; ++s) {
      const bf16x8 A = *(const bf16x8*)(sK + r * 576 + (dw + 16 * s + 8 * h) * 2);
      const bf16x8 B = *(const bf16x8*)(sQ + r * 528 + (dw + 16 * s + 8 * h) * 2);
      pt = MFMA(A, B, pt);
    }
#pragma unroll
    for (int x = 0; x < 16; ++x) if (crow(x, h) > r) pt[x] = 0.f;
    const bf16x8 pb0 = pack8<0>(pt), pb1 = pack8<1>(pt);
    f32x16 ot;
#pragma unroll
    for (int x = 0; x < 16; ++x) ot[x] = 0.f;
    {
      const char* vb = sV + (4 * h + q4) * 64 + (16 * blk + 4 * p4) * 2;
      const bf16x8 A0 = cat8(tr_read(vb), tr_read(vb + 8 * 64));
      const bf16x8 A1 = cat8(tr_read(vb + 16 * 64), tr_read(vb + 24 * 64));
      ot = MFMA(A0, pb0, ot); ot = MFMA(A1, pb1, ot);
    }
    {
      const char* qb = sQ + r * 528 + (dw + 4 * h) * 2;
      const bf16x8 B00 = cat8(*(const s16x4*)(qb), *(const s16x4*)(qb + 16));
      const bf16x8 B01 = cat8(*(const s16x4*)(qb + 32), *(const s16x4*)(qb + 48));
      const bf16x8 B10 = cat8(*(const s16x4*)(qb + 64), *(const s16x4*)(qb + 80));
      const bf16x8 B11 = cat8(*(const s16x4*)(qb + 96), *(const s16x4*)(qb + 112));
      ot = MFMA(pack8<0>(S0), B00, ot); ot = MFMA(pack8<1>(S0), B01, ot);
      ot = MFMA(pack8<0>(S1), B10, ot); ot = MFMA(pack8<1>(S1), B11, ot);
    }
    {
      const char* vb = sV + (8 * h + q4) * 64 + (16 * blk + 4 * p4) * 2;
      const bf16x8 Bv0 = cat8(tr_read(vb), tr_read(vb + 4 * 64));
      const bf16x8 Bv1 = cat8(tr_read(vb + 16 * 64), tr_read(vb + 20 * 64));
      const char* kb = sK + (8 * h + q4) * 576 + (dw + 16 * blk + 4 * p4) * 2;
      const bf16x8 A00 = cat8(tr_read(kb), tr_read(kb + 4 * 576));
      const bf16x8 A01 = cat8(tr_read(kb + 16 * 576), tr_read(kb + 20 * 576));
      const bf16x8 A10 = cat8(tr_read(kb + 64), tr_read(kb + 64 + 4 * 576));
      const bf16x8 A11 = cat8(tr_read(kb + 64 + 16 * 576), tr_read(kb + 64 + 20 * 576));
      S0 = MFMA(A00, Bv0, S0); S0 = MFMA(A01, Bv1, S0);
      S1 = MFMA(A10, Bv0, S1); S1 = MFMA(A11, Bv1, S1);
#pragma unroll
      for (int x = 0; x < 16; ++x) { S0[x] *= sEb[dw + crow(x, h)]; S1[x] *= sEb[dw + 32 + crow(x, h)]; }
    }
#pragma unroll
    for (int x = 0; x < 16; ++x) sRed[(w * 32 + crow(x, h)) * 33 + r] = ot[x];
    __syncthreads();
    {
      const int tok = tid >> 3, dvq = (tid & 7) * 4;
      const int pp = 32 * c - 16 + tok;
      float o[4];
#pragma unroll
      for (int e = 0; e < 4; ++e) o[e] = sRed[(dvq + e) * 33 + tok] + sRed[(32 + dvq + e) * 33 + tok] + sRed[(64 + dvq + e) * 33 + tok] + sRed[(96 + dvq + e) * 33 + tok];
      float ss = o[0] * o[0] + o[1] * o[1] + o[2] * o[2] + o[3] * o[3];
      ss += dpp_x1(ss); ss += dpp_x2(ss); ss += dpp_m8(ss);
      if (pp >= 0 && !dry) {
        const size_t t = (size_t)b * LL + pp;
        if ((tid & 7) == 0) ssqo[(t * 4 + head) * 16 + slice] = ss;
        u32x2 ov;
        ov[0] = pack2(o[0] * silu(bflo(rcur[0])), o[1] * silu(bfhi(rcur[0])));
        ov[1] = pack2(o[2] * silu(bflo(rcur[1])), o[3] * silu(bfhi(rcur[1])));
        *(u32x2*)(vo + t * 2048 + head * 512 + slice * 32 + dvq) = ov;
      }
    }
    __syncthreads();
  };
  ScanRegs RA;
  __syncthreads();
  load(0, RA);
  for (int c = 0; c < 65; ++c) step(c, RA);
}

DI void cumsum_unit(const Params& p, int bh, int tid, char* smem) {
  const int w = tid >> 6, lane = tid & 63; const int b = bh >> 4, hd = bh & 15;
  const float* flog = (const float*)(p.ws + OFF_FLOG); float* cum = (float*)(p.ws + OFF_CUM) + (size_t)bh * 2112;
  float* sT = (float*)smem;
  float v[9];
#pragma unroll
  for (int e = 0; e < 9; ++e) { const int pp = 9 * tid + e, pos = pp - 48; v[e] = (pos >= 0 && pp < 2112) ? flog[((size_t)b * LL + pos) * 16 + hd] : 0.f; }
#pragma unroll
  for (int e = 1; e < 9; ++e) v[e] += v[e - 1];
  float tot = v[8];
#pragma unroll
  for (int d = 1; d < 64; d <<= 1) { const float n = __shfl_up(tot, d); if (lane >= d) tot += n; }
  __syncthreads();
  if (lane == 63) sT[w] = tot;
  __syncthreads();
  float base = tot - v[8];
  for (int i = 0; i < w; ++i) base += sT[i];
#pragma unroll
  for (int e = 0; e < 9; ++e) { const int pp = 9 * tid + e; if (pp < 2112) cum[pp] = v[e] + base; }
}

DI void attn_unit(const Params& p, int qb, int bh, char* smem, int tid, int dry) {
  const int w = tid >> 6, lane = tid & 63, r = lane & 31, h = lane >> 5;
  const int i16 = lane & 15, q4 = i16 >> 2, p4 = i16 & 3, blk = (lane >> 4) & 1;
  const int b = bh >> 4, hd = bh & 15;
  const int qbase = qb == 0 ? -112 : 16 + 128 * (qb - 1);
  const int ntiles = 2 * qb + 1;
  const u16* kf = (const u16*)(p.ws + OFF_S0) + hd * 128; const u16* vf = (const u16*)(p.ws + OFF_S1) + hd * 128;
  u16* qo = (u16*)(p.ws + OFF_S2) + hd * 128;
  const float* cum = (const float*)(p.ws + OFF_CUM) + (size_t)bh * 2112;
  float* sCum = (float*)(smem + 75776);
  const int qp = qbase + 32 * w + r;
  const size_t tq = (size_t)b * LL + (qp >= 0 ? qp : 0);
  bf16x8 qf[8];
  {
    const u32x4 z4 = {0u, 0u, 0u, 0u};
#pragma unroll
    for (int ks = 0; ks < 8; ++ks) {
      u32x4 v = z4;
      if (qp >= 0) v = *(const u32x4*)(qo + tq * 2048 + 16 * ks + 8 * h);
      qf[ks] = __builtin_bit_cast(bf16x8, v);
    }
  }
  const float cq = qp >= 0 ? cum[qp + 48] : 0.f;
  float ubq;
  {
    float qn2 = 0.f;
#pragma unroll
    for (int ks = 0; ks < 8; ++ks) {
      const u32x4 v = __builtin_bit_cast(u32x4, qf[ks]);
#pragma unroll
      for (int i = 0; i < 4; ++i) { const float x0 = bflo(v[i]), x1 = bfhi(v[i]); qn2 += x0 * x0 + x1 * x1; }
    }
    qn2 += __shfl_xor(qn2, 32);
    ubq = sqrtf(qn2);
  }
  int* sFlag = (int*)(smem + 75776 + 512);
  float* sKm = (float*)(smem + 75776 + 512 + 32);
  float kpart = 0.f;
  {
    const int rlo = (b * LL) >> 7, rhi = (b * LL + LL - 1) >> 7;
    const int rbq = rlo + (tid >> 3), e = tid & 7;
    if (rbq <= rhi) { const int half = b - (rbq * 128) / LL; if (half == (e & 1)) kpart = ((const float*)(p.ws + OFF_KMAXP))[(size_t)(rbq * 16 + hd) * 8 + e]; }
#pragma unroll
    for (int d = 1; d < 64; d <<= 1) kpart = fmaxf(kpart, __shfl_xor(kpart, d));
  }
  f32x16 ot[4];
#pragma unroll
  for (int d = 0; d < 4; ++d)
#pragma unroll
    for (int x = 0; x < 16; ++x) ot[d][x] = 0.f;
  float m = -1e30f, lsum = 0.f;
  u32x4 rk[4], rv[4]; float rc = 0.f, rcl = 0.f;
  auto load = [&](int j) {
    const u32x4 z4 = {0u, 0u, 0u, 0u};
#pragma unroll
    for (int i = 0; i < 4; ++i) {
      const int key = (tid >> 4) + 16 * i; const int kp = 64 * j - 48 + key;
      if (kp >= 0) {
        const size_t off = ((size_t)b * LL + kp) * 2048 + (tid & 15) * 8;
        rk[i] = *(const u32x4*)(kf + off); rv[i] = *(const u32x4*)(vf + off);
      } else { rk[i] = z4; rv[i] = z4; }
    }
    if (tid < 64) rc = cum[64 * j + tid];
    rcl = cum[64 * j + 63];
  };
  auto store = [&](int buf) {
    char* sK = smem + buf * 37888; char* sV = sK + 17408;
#pragma unroll
    for (int i = 0; i < 4; ++i) {
      const int key = (tid >> 4) + 16 * i;
      *(u32x4*)(sK + key * 272 + (tid & 15) * 16) = rk[i]; *(u32x4*)(sV + key * 320 + (tid & 15) * 16) = rv[i];
    }
    if (tid < 64) sCum[buf * 64 + tid] = rc;
  };
  __syncthreads();
  if (lane == 0) sKm[w] = kpart;
  load(ntiles - 1); store((ntiles - 1) & 1);
  __syncthreads();
  {
    const float kmx = fmaxf(fmaxf(fmaxf(sKm[0], sKm[1]), fmaxf(sKm[2], sKm[3])), __uint_as_float(((const u32*)(p.ws + OFF_KMAX))[bh]));
    ubq = ubq * sqrtf(kmx) * 1.02f + 0.01f + cq;
  }
  for (int j = ntiles - 1; j >= 0; --j) {
    const int buf = j & 1;
    if (j > 0) load(j - 1);
    const int kp0 = 64 * j - 48;
    if (kp0 <= qbase + 32 * w + 31) {
      const char* sK = smem + buf * 37888; const char* sV = sK + 17408; const float* sC = sCum + buf * 64;
      f32x16 st[2];
#pragma unroll
      for (int jb = 0; jb < 2; ++jb) {
#pragma unroll
        for (int x = 0; x < 16; ++x) st[jb][x] = 0.f;
#pragma unroll
        for (int ks = 0; ks < 8; ++ks) {
          const bf16x8 A = *(const bf16x8*)(sK + (32 * jb + r) * 272 + (16 * ks + 8 * h) * 2);
          st[jb] = MFMA(A, qf[ks], st[jb]);
        }
      }
      float mloc = -1e30f;
#pragma unroll
      for (int jb = 0; jb < 2; ++jb)
#pragma unroll
        for (int g = 0; g < 4; ++g) {
          const float4 ck = *(const float4*)(sC + 32 * jb + 8 * g + 4 * h);
          const float cka[4] = {ck.x, ck.y, ck.z, ck.w};
#pragma unroll
          for (int e = 0; e < 4; ++e) {
            const int kp = kp0 + 32 * jb + 8 * g + 4 * h + e;
            float v = st[jb][4 * g + e] + (cq - cka[e]);
            if (kp > qp || kp < 0) v = -1e30f;
            st[jb][4 * g + e] = v; mloc = fmaxf(mloc, v);
          }
        }
      mloc = fmaxf(mloc, __shfl_xor(mloc, 32));
      const float mnew = fmaxf(m, mloc);
      const float alpha = __expf(m - mnew);
      m = mnew;
      float ps = 0.f;
#pragma unroll
      for (int jb = 0; jb < 2; ++jb)
#pragma unroll
        for (int x = 0; x < 16; ++x) { const float pe = __expf(st[jb][x] - mnew); st[jb][x] = pe; ps += pe; }
      lsum = lsum * alpha + ps;
#pragma unroll
      for (int d = 0; d < 4; ++d)
#pragma unroll
        for (int x = 0; x < 16; ++x) ot[d][x] *= alpha;
      const bf16x8 pb00 = pack8<0>(st[0]), pb01 = pack8<1>(st[0]), pb10 = pack8<0>(st[1]), pb11 = pack8<1>(st[1]);
#pragma unroll
      for (int d = 0; d < 4; ++d) {
        const char* vb = sV + (4 * h + q4) * 320 + (32 * d + 16 * blk + 4 * p4) * 2;
        const bf16x8 A00 = cat8(tr_read(vb), tr_read(vb + 8 * 320));
        const bf16x8 A01 = cat8(tr_read(vb + 16 * 320), tr_read(vb + 24 * 320));
        const bf16x8 A10 = cat8(tr_read(vb + 32 * 320), tr_read(vb + 40 * 320));
        const bf16x8 A11 = cat8(tr_read(vb + 48 * 320), tr_read(vb + 56 * 320));
        ot[d] = MFMA(A00, pb00, ot[d]); ot[d] = MFMA(A01, pb01, ot[d]);
        ot[d] = MFMA(A10, pb10, ot[d]); ot[d] = MFMA(A11, pb11, ot[d]);
      }
    }
    if (j > 0) {
      store(buf ^ 1);
      const bool done = (qp < 0) || (ubq - rcl - m < -110.f);
      const bool wall = __ballot(done) == ~0ull;
      if (lane == 0) sFlag[buf * 4 + w] = wall ? 1 : 0;
    }
    __syncthreads();
    if (j > 0 && (sFlag[buf * 4] & sFlag[buf * 4 + 1] & sFlag[buf * 4 + 2] & sFlag[buf * 4 + 3])) break;
  }
  const float ltot = lsum + __shfl_xor(lsum, 32);
  const float inv = 1.f / ltot;
  if (qp >= 0 && !dry) {
#pragma unroll
    for (int d = 0; d < 4; ++d)
#pragma unroll
      for (int g = 0; g < 4; ++g) {
        u32x2 ov;
        ov[0] = pack2(ot[d][4 * g] * inv, ot[d][4 * g + 1] * inv); ov[1] = pack2(ot[d][4 * g + 2] * inv, ot[d][4 * g + 3] * inv);
        *(u32x2*)(qo + tq * 2048 + 32 * d + 8 * g + 4 * h) = ov;
      }
  }
}

DI void final_unit(const Params& p, int u, int tid) {
  const int w = tid >> 6, l = tid & 63; const size_t rr = (size_t)u * 4 + w;
  float* orow = p.out + rr * 1024; const u16* hr = (const u16*)orow;
  const u32x4 h0 = *(const u32x4*)(hr + 16 * l), h1 = *(const u32x4*)(hr + 16 * l + 8);
  const u32x4 l0 = *(const u32x4*)(hr + 1024 + 16 * l), l1 = *(const u32x4*)(hr + 1024 + 16 * l + 8);
  float v[16];
#pragma unroll
  for (int i = 0; i < 4; ++i) {
    v[2 * i] = bflo(h0[i]) + bflo(l0[i]); v[2 * i + 1] = bfhi(h0[i]) + bfhi(l0[i]);
    v[8 + 2 * i] = bflo(h1[i]) + bflo(l1[i]); v[8 + 2 * i + 1] = bfhi(h1[i]) + bfhi(l1[i]);
  }
  float ss = 0.f;
#pragma unroll
  for (int i = 0; i < 16; ++i) ss += v[i] * v[i];
#pragma unroll
  for (int d = 1; d < 64; d <<= 1) ss += __shfl_xor(ss, d);
  const float rs = rsqrtf(ss * (1.f / 1024.f) + 1e-6f);
#pragma unroll
  for (int i = 0; i < 4; ++i) {
    const float4 g = *(const float4*)(p.final_g + 16 * l + 4 * i);
    float4 o; o.x = v[4 * i] * rs * g.x; o.y = v[4 * i + 1] * rs * g.y; o.z = v[4 * i + 2] * rs * g.z; o.w = v[4 * i + 3] * rs * g.w;
    *(float4*)(orow + 16 * l + 4 * i) = o;
  }
}


#define XB_TMO      128
#define XB_XCNT(j)  (256  + 64 * (j))
#define XB_XSUB(j)  (1280 + 64 * (j))
#define XB_XGEN(j)  (2304 + 64 * (j))
#define XB_TOP      3328
#define XB_TOPGEN   3392
#define XB_SPIN_CAP (1u << 20)
#define LAS __attribute__((address_space(3)))
DI unsigned xb_ld(unsigned* p) { return __hip_atomic_load(p, __ATOMIC_RELAXED, __HIP_MEMORY_SCOPE_AGENT); }
DI unsigned xb_add(unsigned* p, unsigned v) { return __hip_atomic_fetch_add(p, v, __ATOMIC_RELAXED, __HIP_MEMORY_SCOPE_AGENT); }
DI unsigned xb_xcc_id() { return (unsigned)__builtin_amdgcn_s_getreg((3 << 11) | 20) & 0xFu; }
#define XB_SPIN(cond, bar) do { unsigned _sp = 0; while (cond) { __builtin_amdgcn_s_sleep(1); \
    if ((++_sp & 255u) == 0u) { if (xb_ld(&(bar)[XB_TMO])) break; if (_sp > XB_SPIN_CAP) { atomicAdd(&(bar)[XB_TMO], 1u); break; } } } } while (0)
struct XcdBarrier { unsigned* bar; unsigned x; volatile LAS unsigned* st; };
DI XcdBarrier xcd_barrier_post(unsigned* bar, volatile LAS unsigned* st) {
  XcdBarrier b; b.bar = bar; b.x = xb_xcc_id(); b.st = st;
  if (threadIdx.x == 0) st[3] = xb_add(&bar[XB_XCNT(b.x)], 1u);
  return b;
}
DI void xcd_barrier_complete(unsigned* bar, unsigned x, unsigned& nloc, unsigned& nx, unsigned& xi) {
  const unsigned G = gridDim.x * gridDim.y * gridDim.z;
  unsigned sum, cnt, mine, sp = 0u;
  for (;;) {
    sum = 0u; cnt = 0u; mine = 0u; xi = 0u;
#pragma unroll
    for (unsigned j = 0; j < 16; ++j) { const unsigned c = xb_ld(&bar[XB_XCNT(j)]); sum += c; cnt += (c > 0u) ? 1u : 0u; mine = (j == x) ? c : mine; xi += (c > 0u && j < x) ? 1u : 0u; }
    if (sum == G) break;
    __builtin_amdgcn_s_sleep(1);
    if ((++sp & 255u) == 0u) { if (xb_ld(&bar[XB_TMO])) break; if (sp > XB_SPIN_CAP) { atomicAdd(&bar[XB_TMO], 1u); break; } }
  }
  nloc = mine > 0u ? mine : 1u; nx = cnt > 0u ? cnt : 1u;
}
DI void xcd_barrier(const XcdBarrier& b) {
  asm volatile("s_waitcnt vmcnt(0)" ::: "memory");
  __syncthreads();
  if (threadIdx.x == 0) {
    unsigned* bar = b.bar;
    __builtin_amdgcn_s_waitcnt(0);
    unsigned nloc = b.st[0], nx = b.st[1];
    if (nloc == 0u) { unsigned xi; xcd_barrier_complete(bar, b.x, nloc, nx, xi); b.st[0] = nloc; b.st[1] = nx; b.st[2] = xi; }
    const unsigned old = xb_add(&bar[XB_XSUB(b.x)], 1u);
    const unsigned gen = old / nloc;
    if (old + 1u == (gen + 1u) * nloc) {
      __builtin_amdgcn_fence(__ATOMIC_RELEASE, "agent");
      asm volatile("s_waitcnt vmcnt(0)" ::: "memory");
      const unsigned og = xb_add(&bar[XB_TOP], 1u);
      const unsigned tg = og / nx;
      if (og + 1u == (tg + 1u) * nx) xb_add(&bar[XB_TOPGEN], 1u);
      else XB_SPIN(xb_ld(&bar[XB_TOPGEN]) == tg, bar);
      __builtin_amdgcn_fence(__ATOMIC_ACQUIRE, "agent");
      xb_add(&bar[XB_XGEN(b.x)], 1u);
      asm volatile("s_waitcnt vmcnt(0)" ::: "memory");
    } else {
      XB_SPIN(xb_ld(&bar[XB_XGEN(b.x)]) == gen, bar);
      __builtin_amdgcn_fence(__ATOMIC_ACQUIRE, "agent");
      asm volatile("s_waitcnt vmcnt(0)" ::: "memory");
    }
  }
  __syncthreads();
}

constexpr int N_PHASES = 19;
struct Sched { int xi, nx, lr, nloc; };
DI void attn_phase(const Params& p, char* smem, int tid, int dry, const Sched& s) {
  const bool local = (s.nx == 8 && s.nloc == 64);
  const int k = s.lr >> 4;
  const int n = local ? (k == 0 ? 5 : 4) : (2176 - (int)blockIdx.x + (int)gridDim.x - 1) / (int)gridDim.x;
  for (int i = 0; i < n; ++i) {
    int qb, bh;
    if (local) { bh = s.xi + 8 * (s.lr & 15); qb = i == 0 ? 16 - k : i == 1 ? 9 + k : i == 2 ? 8 - k : i == 3 ? 1 + k : 0; }
    else {
      const int u = blockIdx.x + i * gridDim.x;
      if (u >= 2048) { qb = 0; bh = u - 2048; }
      else { const int rnd = u >> 9, kk = (u >> 7) & 3; bh = u & 127; qb = rnd == 0 ? 16 - kk : rnd == 1 ? 9 + kk : rnd == 2 ? 8 - kk : 1 + kk; }
    }
    attn_unit(p, qb, bh, smem, tid, dry);
  }
}

template <int KIND> DI void gemm_phase(const Params& p, int layer, int ncb, char* smem, int tid, int dry, const Sched& s) {
  const int nmain = 129 / s.nx, nlo = 129 - nmain * s.nx;
  const int nmt = nmain * ncb, L = nlo * ncb;
  const int nt = nmt + (L - s.xi + s.nx - 1) / s.nx;
  const int nfull = (nt / s.nloc) * s.nloc;
  auto decode = [&](int tl, int& rb, int& cb) {
    if (tl < nmt) { cb = tl / nmain; rb = s.xi * nmain + (tl - cb * nmain); }
    else { const int l = (tl - nmt) * s.nx + s.xi; const int q = l / ncb; rb = nmain * s.nx + q; cb = l - q * ncb; }
  };
  for (int tl = s.lr; tl < nfull; tl += s.nloc) { int rb, cb; decode(tl, rb, cb); gemm_tile<KIND, 2>(p, layer, rb, cb, 0, 0, smem, tid, dry); }
  for (int su = s.lr; su < 4 * (nt - nfull); su += s.nloc) {
    int rb, cb; decode(nfull + (su >> 2), rb, cb);
    gemm_tile<KIND, 1>(p, layer, rb, cb, (su >> 1) & 1, su & 1, smem, tid, dry);
  }
}
#define PHASE(n, body) if (ph0 <= (n) && (n) < ph1) { Sched sch; if (coop && (n) > 0) { sch.nloc = (int)xst[0]; sch.nx = (int)xst[1]; sch.xi = (int)xst[2]; sch.lr = (int)xst[3]; } \
    else { sch.nx = 8; sch.xi = blockIdx.x & 7; sch.lr = blockIdx.x >> 3; sch.nloc = (gridDim.x + 7 - sch.xi) >> 3; } (void)sch; for (int rep = (probe == (n)) ? 0 : 1; rep < 2; ++rep) { const int dry = (rep == 0); (void)dry; body if (rep == 0) xcd_barrier(xb); } } \
  if (coop && ph0 <= (n) && (n) + 1 < ph1) xcd_barrier(xb);
__global__ void __launch_bounds__(256, 2) fwd_megakernel(Params p, int ph0, int ph1, int coop, int probe) {
  __shared__ __attribute__((aligned(16))) char smem[SMEM_BYTES];
  const int tid = threadIdx.x;
  volatile LAS unsigned* xst = (volatile LAS unsigned*)(smem + SMEM_BYTES - 16);
  if (tid == 0) { xst[0] = 0u; xst[1] = 0u; xst[2] = 0u; xst[3] = 0u; }
  __syncthreads();
  XcdBarrier xb = xcd_barrier_post((unsigned*)(p.ws + OFF_BAR), xst);
  if (coop == 2) cg::this_grid().sync();
  PHASE(0, for (int i = blockIdx.x * 256 + tid; i < 129 * 16 * 8; i += gridDim.x * 256) ((float*)(p.ws + OFF_KMAXP))[i] = 0.f;
        for (int u = blockIdx.x; u < CONV_GLA_UNITS + TT / 4; u += gridDim.x) {
        if (u < CONV_GLA_UNITS) conv_gla(p, u, (float*)smem, tid); else h0_unit(p, u - CONV_GLA_UNITS, tid); })
  PHASE(1, gemm_phase<G_GLAIN>(p, 0, 49, smem, tid, dry, sch);)
  PHASE(2, for (int u = blockIdx.x; u < 1040; u += gridDim.x) prep_unit(p, 0, u, tid, dry, smem);)
  PHASE(3, for (int tl = sch.lr; ; tl += sch.nloc) { const int bhp = sch.xi + sch.nx * (tl >> 4); if (bhp >= 32) break; scan_unit(p, bhp * 16 + (tl & 15), smem, tid, dry); })
  PHASE(4, gemm_phase<G_GLAOUT>(p, 0, 8, smem, tid, dry, sch);)
  PHASE(5, gemm_phase<G_GLAIN>(p, 1, 49, smem, tid, dry, sch);)
  PHASE(6, for (int u = blockIdx.x; u < 1040 + CONV_FOX_UNITS; u += gridDim.x) {
        if (u < 1040) prep_unit(p, 1, u, tid, dry, smem); else conv_fox(p, u - 1040, (float*)smem, tid); })
  PHASE(7, for (int tl = sch.lr; ; tl += sch.nloc) { const int bhp = sch.xi + sch.nx * (tl >> 4); if (bhp >= 32) break; scan_unit(p, bhp * 16 + (tl & 15), smem, tid, dry); })
  PHASE(8, gemm_phase<G_GLAOUT>(p, 1, 8, smem, tid, dry, sch);)
  PHASE(9, gemm_phase<G_KVQ>(p, 0, 49, smem, tid, dry, sch);)
  PHASE(10, for (int u = blockIdx.x; u < 128; u += gridDim.x) cumsum_unit(p, u, tid, smem);)
  PHASE(11, attn_phase(p, smem, tid, dry, sch);)
  PHASE(12, gemm_phase<G_RGATE>(p, 0, 16, smem, tid, dry, sch);)
  PHASE(13, gemm_phase<G_FOXOUT>(p, 0, 8, smem, tid, dry, sch);)
  PHASE(14, gemm_phase<G_Q1>(p, 1, 16, smem, tid, dry, sch);)
  PHASE(15, attn_phase(p, smem, tid, dry, sch);)
  PHASE(16, gemm_phase<G_RGATE>(p, 1, 16, smem, tid, dry, sch);)
  PHASE(17, gemm_phase<G_FOXOUT>(p, 1, 8, smem, tid, dry, sch);)
  PHASE(18, for (int u = blockIdx.x; u < 4096; u += gridDim.x) final_unit(p, u, tid);)
}

extern "C" void kernel_launch(void* const* d_in, const int* in_sizes, int n_in, void* d_out, int out_size, void* d_ws,
                              size_t ws_size, hipStream_t stream) {
  Params p{};
  p.x = (const float*)d_in[0]; p.meta = (const float*)d_in[1]; p.norm_g = (const float*)d_in[2];
  p.gla_w_in = (const float*)d_in[3]; p.gla_w_gate_up = (const float*)d_in[4]; p.gla_b_gate = (const float*)d_in[5];
  p.gla_hn_g = (const float*)d_in[6]; p.gla_w_out = (const float*)d_in[7]; p.kv_norm_g = (const float*)d_in[8];
  p.fox_w_kv = (const float*)d_in[9]; p.fox_b_forget = (const float*)d_in[10]; p.fox_w_in = (const float*)d_in[11];
  p.fox_w_out = (const float*)d_in[12]; p.final_g = (const float*)d_in[13];
  p.out = (float*)d_out; p.ws = (char*)d_ws;
  if (ws_size < WS_END) { fprintf(stderr, "workspace too small: %zu < %zu\n", ws_size, (size_t)WS_END); return; }
  static int grid_blocks = 0;
  if (!grid_blocks) {
    int dev = 0, cus = 0, per_cu = 0;
    hipGetDevice(&dev);
    hipDeviceGetAttribute(&cus, hipDeviceAttributeMultiprocessorCount, dev);
    hipOccupancyMaxActiveBlocksPerMultiprocessor(&per_cu, fwd_megakernel, 256, 0);
    if (per_cu > 2) per_cu = 2;
    grid_blocks = cus * per_cu;
  }
  hipMemsetAsync((char*)d_ws + OFF_BAR, 0, BAR_BYTES, stream);
  int ph0 = 0, ph1 = N_PHASES, coop = 1, probe = PROBE_PHASE;
  void* args[] = {&p, &ph0, &ph1, &coop, &probe};
  hipError_t e = hipLaunchCooperativeKernel((void*)fwd_megakernel, dim3(grid_blocks), dim3(256), args, 0, stream);
  if (e != hipSuccess) fprintf(stderr, "cooperative launch failed: %s (grid %d)\n", hipGetErrorString(e), grid_blocks);
}
```
